# Optimizing an MI355X kernel written in HIP

```python
import math
import jax, jax.numpy as jnp
from jax import lax
import numpy as np

D_MODEL = 2048
BATCH = 2
SEQ = 4096
DEPTH = 4

HEAD_DIM = 128
N_HEADS = D_MODEL // HEAD_DIM
WIDTH = N_HEADS * HEAD_DIM
N_MIXERS = 3
ROPE_THETA = 10000.0
EPS = 1e-6
ATTN_SCALE = HEAD_DIM ** -0.5
NEG = -1e30
FORCE = 1e30
TINY = 1e-30
MOBA_BLOCK = 256
MOBA_TOPK = 3
MOBA_Q_CHUNK = 16
SB_Q_BLOCK = 128
NSA_KV_HEADS = 4
NSA_HPG = N_HEADS // NSA_KV_HEADS
KV_WIDTH = NSA_KV_HEADS * HEAD_DIM
CMP_BLOCK = 32
CMP_STRIDE = 16
SLC_BLOCK = 64
SLC_TOPK = 16
WINDOW = 512
NSA_Q_CHUNK = 32
WIN_Q_BLOCK = 128
NSA_IN_COLS = WIDTH + 6 * KV_WIDTH + WIDTH + 3 * N_HEADS

kernel_name = 'hybrid_moba_stickbreak_nsa_trunk'


def rmsnorm(x, g):
    x32 = x.astype(jnp.float32)
    y = x32 * lax.rsqrt(jnp.mean(x32 * x32, axis=-1, keepdims=True) + EPS)
    return (y * g.astype(jnp.float32)).astype(x.dtype)


def rope(x, pos):
    half = x.shape[-1] // 2
    inv_freq = jnp.exp(-math.log(ROPE_THETA) * jnp.arange(half, dtype=jnp.float32) / half)
    ang = pos.astype(jnp.float32)[:, None] * inv_freq[None, :]
    cos, sin = jnp.cos(ang), jnp.sin(ang)
    x32 = x.astype(jnp.float32)
    x1, x2 = x32[..., :half], x32[..., half:]
    return jnp.concatenate([x1 * cos - x2 * sin, x2 * cos + x1 * sin], axis=-1).astype(x.dtype)


def split_heads(t, n):
    B, S, _ = t.shape
    return t.reshape(B, S, n, HEAD_DIM).transpose(0, 2, 1, 3)


def merge_heads(o):
    B, H, S, D = o.shape
    return o.transpose(0, 2, 1, 3).reshape(B, S, H * D)


def masked_softmax(logits, mask):
    logits = jnp.where(mask, logits, NEG)
    m = jnp.max(logits, axis=-1, keepdims=True)
    e = jnp.where(mask, jnp.exp(logits - m), 0.0)
    return e / jnp.maximum(jnp.sum(e, axis=-1, keepdims=True), TINY)


def gated_output(x, o, gate, w_out):
    y = merge_heads(o).astype(x.dtype) * jax.nn.silu(gate)
    return x + y @ w_out


def moba_attention(q, k, v):
    B, H, S, D = q.shape
    nb = -(-S // MOBA_BLOCK)
    pad = nb * MOBA_BLOCK - S
    kb = jnp.pad(k, ((0, 0), (0, 0), (0, pad), (0, 0))).reshape(B, H, nb, MOBA_BLOCK, D)
    vb = jnp.pad(v, ((0, 0), (0, 0), (0, pad), (0, 0))).reshape(B, H, nb, MOBA_BLOCK, D)
    k_mean = jnp.mean(kb.astype(jnp.float32), axis=3)
    n_sel = min(MOBA_TOPK, nb - 1)
    nc = S // MOBA_Q_CHUNK
    q_chunks = jnp.moveaxis(q.reshape(B, H, nc, MOBA_Q_CHUNK, D), 2, 0)
    bi = jnp.arange(B)[:, None, None, None]
    hi = jnp.arange(H)[None, :, None, None]
    blk_pos = jnp.arange(MOBA_BLOCK)
    blk_ids = jnp.arange(nb)

    def one_chunk(args):
        c, qc = args
        t = c * MOBA_Q_CHUNK + jnp.arange(MOBA_Q_CHUNK)
        cur = (c * MOBA_Q_CHUNK) // MOBA_BLOCK
        k_own = lax.dynamic_index_in_dim(kb, cur, axis=2, keepdims=False)
        v_own = lax.dynamic_index_in_dim(vb, cur, axis=2, keepdims=False)
        s_own = jnp.einsum('bhqd,bhkd->bhqk', qc, k_own).astype(jnp.float32) * ATTN_SCALE
        own_mask = (cur * MOBA_BLOCK + blk_pos)[None, :] <= t[:, None]
        s_own = jnp.where(own_mask, s_own, NEG)
        if n_sel == 0:
            p = jax.nn.softmax(s_own, axis=-1)
            return jnp.einsum('bhqk,bhkd->bhqd', p.astype(v.dtype), v_own)
        gate = jnp.einsum('bhqd,bhnd->bhqn', qc.astype(jnp.float32), k_mean)
        gate = jnp.where(blk_ids < cur, gate, NEG)
        _, idx = lax.top_k(gate, n_sel)
        sel_valid = idx < cur
        k_sel = kb[bi, hi, idx]
        v_sel = vb[bi, hi, idx]
        s_sel = jnp.einsum('bhqd,bhqnkd->bhqnk', qc, k_sel).astype(jnp.float32) * ATTN_SCALE
        s_sel = jnp.where(sel_valid[..., None], s_sel, NEG).reshape(B, H, MOBA_Q_CHUNK, n_sel * MOBA_BLOCK)
        p = jax.nn.softmax(jnp.concatenate([s_sel, s_own], axis=-1), axis=-1)
        p_sel = p[..., :n_sel * MOBA_BLOCK].reshape(B, H, MOBA_Q_CHUNK, n_sel, MOBA_BLOCK)
        p_own = p[..., n_sel * MOBA_BLOCK:]
        return (jnp.einsum('bhqnk,bhqnkd->bhqd', p_sel.astype(v.dtype), v_sel)
                + jnp.einsum('bhqk,bhkd->bhqd', p_own.astype(v.dtype), v_own))

    out = lax.map(one_chunk, (jnp.arange(nc), q_chunks))
    return jnp.moveaxis(out, 0, 2).reshape(B, H, S, D)


def moba_layer(x, norm, w_in, q_norm, k_norm, w_out):
    pos = jnp.arange(x.shape[1])
    h = rmsnorm(x, norm) @ w_in
    q, k, v, gate = jnp.split(h, [WIDTH, 2 * WIDTH, 3 * WIDTH], axis=-1)
    q = rope(rmsnorm(split_heads(q, N_HEADS), q_norm), pos)
    k = rope(rmsnorm(split_heads(k, N_HEADS), k_norm), pos)
    o = moba_attention(q, k, split_heads(v, N_HEADS))
    return gated_output(x, o, gate, w_out)


def stick_breaking_attention(q, k, v):
    B, H, S, D = q.shape
    nqb = S // SB_Q_BLOCK
    q_blocks = jnp.moveaxis(q.reshape(B, H, nqb, SB_Q_BLOCK, D), 2, 0)
    s_pos = jnp.arange(S)

    def one_block(args):
        c, qb = args
        t = c * SB_Q_BLOCK + jnp.arange(SB_Q_BLOCK)
        z = jnp.einsum('bhqd,bhkd->bhqk', qb, k).astype(jnp.float32) * ATTN_SCALE
        past = s_pos[None, :] < t[:, None]
        log_keep = jnp.where(past, jax.nn.log_sigmoid(-z), 0.0)
        log_after = lax.cumsum(log_keep, axis=3, reverse=True) - log_keep
        a = jnp.where(past, jnp.exp(jax.nn.log_sigmoid(z) + log_after), 0.0)
        return jnp.einsum('bhqk,bhkd->bhqd', a.astype(v.dtype), v)

    out = lax.map(one_block, (jnp.arange(nqb), q_blocks))
    return jnp.moveaxis(out, 0, 2).reshape(B, H, S, D)


def stick_breaking_layer(x, norm, w_in, w_out):
    h = rmsnorm(x, norm) @ w_in
    q, k, v, gate = jnp.split(h, [WIDTH, 2 * WIDTH, 3 * WIDTH], axis=-1)
    o = stick_breaking_attention(split_heads(q, N_HEADS), split_heads(k, N_HEADS), split_heads(v, N_HEADS))
    return gated_output(x, o, gate, w_out)


def nsa_compressed(qg, kc, vc, pos_c):
    S = qg.shape[3]
    t = jnp.arange(S)
    logits = jnp.einsum('bgrqd,bgnd->bgrqn', qg, kc).astype(jnp.float32) * ATTN_SCALE
    p = masked_softmax(logits, pos_c[None, :] <= t[:, None])
    o = jnp.einsum('bgrqn,bgnd->bgrqd', p.astype(vc.dtype), vc)
    return o, jnp.sum(p, axis=2)


def nsa_selected(qg, ks, vs, p_cmp):
    B, G, R, S, D = qg.shape
    n_cmp = p_cmp.shape[-1]
    n_slc = S // SLC_BLOCK
    c_start = jnp.arange(n_cmp) * CMP_STRIDE
    s_start = jnp.arange(n_slc) * SLC_BLOCK
    overlap = ((c_start[:, None] < s_start[None, :] + SLC_BLOCK)
               & (c_start[:, None] + CMP_BLOCK > s_start[None, :])).astype(jnp.float32)
    imp = jnp.einsum('bgqn,nj->bgqj', p_cmp, overlap)
    t = jnp.arange(S)
    cur = t // SLC_BLOCK
    j = jnp.arange(n_slc)
    forced = (j[None, :] == 0) | (j[None, :] == cur[:, None]) | (j[None, :] == cur[:, None] - 1)
    imp = jnp.where(forced, FORCE, imp)
    imp = jnp.where(j[None, :] <= cur[:, None], imp, NEG)
    n_sel = min(SLC_TOPK, n_slc)
    _, idx = lax.top_k(imp, n_sel)
    ksb = ks.reshape(B, G, n_slc, SLC_BLOCK, D)
    vsb = vs.reshape(B, G, n_slc, SLC_BLOCK, D)
    nc = S // NSA_Q_CHUNK
    q_chunks = jnp.moveaxis(qg.reshape(B, G, R, nc, NSA_Q_CHUNK, D), 3, 0)
    idx_chunks = jnp.moveaxis(idx.reshape(B, G, nc, NSA_Q_CHUNK, n_sel), 2, 0)
    bi = jnp.arange(B)[:, None, None, None]
    gi = jnp.arange(G)[None, :, None, None]
    blk_pos = jnp.arange(SLC_BLOCK)

    def one_chunk(args):
        c, qc, ic = args
        tc = c * NSA_Q_CHUNK + jnp.arange(NSA_Q_CHUNK)
        k_sel = ksb[bi, gi, ic]
        v_sel = vsb[bi, gi, ic]
        key_pos = ic[..., None] * SLC_BLOCK + blk_pos
        mask = key_pos <= tc[None, None, :, None, None]
        logits = jnp.einsum('bgrqd,bgqnkd->bgrqnk', qc, k_sel).astype(jnp.float32) * ATTN_SCALE
        logits = jnp.where(mask[:, :, None], logits, NEG).reshape(B, G, R, NSA_Q_CHUNK, n_sel * SLC_BLOCK)
        p = jax.nn.softmax(logits, axis=-1).reshape(B, G, R, NSA_Q_CHUNK, n_sel, SLC_BLOCK)
        return jnp.einsum('bgrqnk,bgqnkd->bgrqd', p.astype(vs.dtype), v_sel)

    out = lax.map(one_chunk, (jnp.arange(nc), q_chunks, idx_chunks))
    return jnp.moveaxis(out, 0, 3).reshape(B, G, R, S, D)


def nsa_window(qg, kw, vw):
    B, G, R, S, D = qg.shape
    nqb = S // WIN_Q_BLOCK
    span = WINDOW + WIN_Q_BLOCK
    kp = jnp.pad(kw, ((0, 0), (0, 0), (WINDOW, 0), (0, 0)))
    vp = jnp.pad(vw, ((0, 0), (0, 0), (WINDOW, 0), (0, 0)))
    widx = jnp.arange(nqb)[:, None] * WIN_Q_BLOCK + jnp.arange(span)[None, :]
    k_blk = kp[:, :, widx]
    v_blk = vp[:, :, widx]
    qb = qg.reshape(B, G, R, nqb, WIN_Q_BLOCK, D)
    logits = jnp.einsum('bgrcqd,bgckd->bgrcqk', qb, k_blk).astype(jnp.float32) * ATTN_SCALE
    s_pos = widx - WINDOW
    t_pos = jnp.arange(nqb)[:, None] * WIN_Q_BLOCK + jnp.arange(WIN_Q_BLOCK)[None, :]
    diff = t_pos[:, :, None] - s_pos[:, None, :]
    mask = (diff >= 0) & (diff < WINDOW) & (s_pos[:, None, :] >= 0)
    p = jax.nn.softmax(jnp.where(mask, logits, NEG), axis=-1)
    o = jnp.einsum('bgrcqk,bgckd->bgrcqd', p.astype(vw.dtype), v_blk)
    return o.reshape(B, G, R, S, D)


def nsa_layer(x, norm, w_in, q_norm, kc_norm, ks_norm, kw_norm, cmp_wk, cmp_wv, cmp_pos, w_out):
    B, S, _ = x.shape
    pos = jnp.arange(S)
    h = rmsnorm(x, norm) @ w_in
    cuts = [WIDTH + i * KV_WIDTH for i in range(7)] + [2 * WIDTH + 6 * KV_WIDTH]
    q, kc, vc, ks, vs, kw, vw, gate, bgate = jnp.split(h, cuts, axis=-1)
    q = rope(rmsnorm(split_heads(q, N_HEADS), q_norm), pos)
    ks = rope(rmsnorm(split_heads(ks, NSA_KV_HEADS), ks_norm), pos)
    kw = rope(rmsnorm(split_heads(kw, NSA_KV_HEADS), kw_norm), pos)
    kc, vc = split_heads(kc, NSA_KV_HEADS), split_heads(vc, NSA_KV_HEADS)
    vs, vw = split_heads(vs, NSA_KV_HEADS), split_heads(vw, NSA_KV_HEADS)
    n_cmp = (S - CMP_BLOCK) // CMP_STRIDE + 1
    cidx = jnp.arange(n_cmp)[:, None] * CMP_STRIDE + jnp.arange(CMP_BLOCK)[None, :]
    kc_c = jnp.einsum('bgnld,lde->bgne', kc[:, :, cidx] + cmp_pos, cmp_wk)
    vc_c = jnp.einsum('bgnld,lde->bgne', vc[:, :, cidx] + cmp_pos, cmp_wv)
    pos_c = cidx[:, -1]
    kc_c = rope(rmsnorm(kc_c, kc_norm), pos_c)
    qg = q.reshape(B, NSA_KV_HEADS, NSA_HPG, S, HEAD_DIM)
    o_cmp, p_cmp = nsa_compressed(qg, kc_c, vc_c, pos_c)
    o_slc = nsa_selected(qg, ks, vs, p_cmp)
    o_win = nsa_window(qg, kw, vw)
    g = jax.nn.sigmoid(bgate.astype(jnp.float32)).reshape(B, S, 3, N_HEADS).transpose(2, 0, 3, 1)[..., None]
    shp = (B, N_HEADS, S, HEAD_DIM)
    o = g[0] * o_cmp.reshape(shp) + g[1] * o_slc.reshape(shp) + g[2] * o_win.reshape(shp)
    return gated_output(x, o, gate, w_out)


def setup_inputs(seed: int = 0) -> dict:
    key = jax.random.key(seed)
    keys = iter(jax.random.split(key, 64))

    def normal(shape, scale):
        return jax.random.normal(next(keys), shape, jnp.float32) * scale

    def gain(n):
        return 1.0 + 0.1 * normal((n,), 1.0)

    inputs = {'x': normal((BATCH, SEQ, D_MODEL), 1.0)}
    for i in range(DEPTH):
        p = 'l%d_' % i
        kind = i % N_MIXERS
        inputs[p + 'norm'] = gain(D_MODEL)
        if kind == 0:
            inputs[p + 'w_in'] = normal((D_MODEL, 4 * WIDTH), D_MODEL ** -0.5)
            inputs[p + 'q_norm'] = gain(HEAD_DIM)
            inputs[p + 'k_norm'] = gain(HEAD_DIM)
        elif kind == 1:
            inputs[p + 'w_in'] = normal((D_MODEL, 4 * WIDTH), D_MODEL ** -0.5)
        else:
            inputs[p + 'w_in'] = normal((D_MODEL, NSA_IN_COLS), D_MODEL ** -0.5)
            inputs[p + 'q_norm'] = gain(HEAD_DIM)
            inputs[p + 'kc_norm'] = gain(HEAD_DIM)
            inputs[p + 'ks_norm'] = gain(HEAD_DIM)
            inputs[p + 'kw_norm'] = gain(HEAD_DIM)
            inputs[p + 'cmp_wk'] = normal((CMP_BLOCK, HEAD_DIM, HEAD_DIM), (CMP_BLOCK * HEAD_DIM) ** -0.5)
            inputs[p + 'cmp_wv'] = normal((CMP_BLOCK, HEAD_DIM, HEAD_DIM), (CMP_BLOCK * HEAD_DIM) ** -0.5)
            inputs[p + 'cmp_pos'] = normal((CMP_BLOCK, HEAD_DIM), 0.1)
        inputs[p + 'w_out'] = normal((WIDTH, D_MODEL), WIDTH ** -0.5)
    return inputs


def reference(x,
              l0_norm, l0_w_in, l0_q_norm, l0_k_norm, l0_w_out,
              l1_norm, l1_w_in, l1_w_out,
              l2_norm, l2_w_in, l2_q_norm, l2_kc_norm, l2_ks_norm, l2_kw_norm,
              l2_cmp_wk, l2_cmp_wv, l2_cmp_pos, l2_w_out,
              l3_norm, l3_w_in, l3_q_norm, l3_k_norm, l3_w_out):
    layer_params = [
        dict(norm=l0_norm, w_in=l0_w_in, q_norm=l0_q_norm, k_norm=l0_k_norm, w_out=l0_w_out),
        dict(norm=l1_norm, w_in=l1_w_in, w_out=l1_w_out),
        dict(norm=l2_norm, w_in=l2_w_in, q_norm=l2_q_norm, kc_norm=l2_kc_norm, ks_norm=l2_ks_norm,
             kw_norm=l2_kw_norm, cmp_wk=l2_cmp_wk, cmp_wv=l2_cmp_wv, cmp_pos=l2_cmp_pos, w_out=l2_w_out),
        dict(norm=l3_norm, w_in=l3_w_in, q_norm=l3_q_norm, k_norm=l3_k_norm, w_out=l3_w_out),
    ]
    mixers = (moba_layer, stick_breaking_layer, nsa_layer)
    for i in range(DEPTH):
        x = mixers[i % N_MIXERS](x, **layer_params[i])
    return x
```

```cpp
#include <hip/hip_runtime.h>
#include <hip/hip_cooperative_groups.h>
#include <cstdio>
#include <cstdint>
namespace cg = cooperative_groups;

typedef unsigned short bf16_t;
using bf16x8 = __attribute__((ext_vector_type(8))) short;
using f32x16 = __attribute__((ext_vector_type(16))) float;
using u32x4v = __attribute__((ext_vector_type(4))) unsigned;
typedef float f32x2_t __attribute__((ext_vector_type(2)));
typedef __bf16 bf16x2_t __attribute__((ext_vector_type(2)));
#define DI __device__ __forceinline__
#define MFMA(a, b, c) __builtin_amdgcn_mfma_f32_32x32x16_bf16((a), (b), (c), 0, 0, 0)

constexpr int SEQ = 4096, DM = 2048, NTOK = 8192;
constexpr float EPS = 1e-6f, SCALE = 0.08838834764831845f, NEGF = -1e30f;
constexpr size_t MB = 1ull << 20;
constexpr size_t WS_WIN = 0, WS_WOUT = 32 * MB, WS_X = 64 * MB, WS_A = 128 * MB, WS_Q = 160 * MB, WS_K = 192 * MB, WS_VT = 224 * MB,
                 WS_G = 256 * MB, WS_OACC = 288 * MB, WS_ROPE = 352 * MB, WS_SSQ = 354 * MB, WS_KMP = 355 * MB, WS_CMPW = 356 * MB,
                 WS_CBIAS = 358 * MB, WS_BAR = 359 * MB, WS_END = 360 * MB;
constexpr int LDS_BYTES = 78848;
constexpr int LDS_XB = 78832;
constexpr int LDS_RED = 73728, LDS_RSD = 73728 + 2048, LDS_IMP = 69632, LDS_SELM = 69632 + 8192;

struct P {
    const float* x;
    const float* norm[4]; const float* w_in[4]; const float* w_out[4];
    const float* qn0; const float* kn0; const float* qn3; const float* kn3;
    const float* qn2; const float* kcn2; const float* ksn2; const float* kwn2;
    const float* cwk; const float* cwv; const float* cpos;
    float* out; unsigned char* ws;
};

DI unsigned cvtpk(float lo, float hi) { f32x2_t v = {lo, hi}; bf16x2_t b = __builtin_convertvector(v, bf16x2_t); return __builtin_bit_cast(unsigned, b); }
DI float bflo(unsigned u) { return __uint_as_float(u << 16); }
DI float bfhi(unsigned u) { return __uint_as_float(u & 0xffff0000u); }
DI int crow(int i, int h) { return (i & 3) + 8 * (i >> 2) + 4 * h; }
DI float sigmoidf_(float x) { return 1.f / (1.f + __expf(-x)); }

DI void conv_tile(const float* __restrict__ src, int K, int N, bf16_t* __restrict__ dst, int tile, float* ldsf, int tid) {
    asm volatile("" : "+v"(tid));
    const int ktiles = K >> 6;
    const int nt = tile / ktiles, kt = tile - nt * ktiles;
    const int n0 = nt * 64, k0 = kt * 64;
#pragma unroll
    for (int i = 0; i < 4; ++i) {
        const int c = tid + 256 * i;
        const int kr = c >> 4, nc = (c & 15) * 4;
        const int n = n0 + nc;
        float4 v = make_float4(0.f, 0.f, 0.f, 0.f);
        if (n < N) v = *(const float4*)(src + (size_t)(k0 + kr) * N + n);
        float* d = ldsf + kr * 65 + nc;
        d[0] = v.x; d[1] = v.y; d[2] = v.z; d[3] = v.w;
    }
    __syncthreads();
#pragma unroll
    for (int i = 0; i < 2; ++i) {
        const int c = tid + 256 * i;
        const int n = c >> 3, kc = (c & 7) * 8;
        const float* s = ldsf + kc * 65 + n;
        uint4 w;
        w.x = cvtpk(s[0], s[65]); w.y = cvtpk(s[130], s[195]); w.z = cvtpk(s[260], s[325]); w.w = cvtpk(s[390], s[455]);
        *(uint4*)(dst + (size_t)(n0 + n) * K + k0 + kc) = w;
    }
    __syncthreads();
}
DI void phase_convert(const float* src, int K, int N, int Npad, bf16_t* dst, float* ldsf, int tid, int bid, int nb) {
    const int ntiles = (Npad >> 6) * (K >> 6);
    for (int t = bid; t < ntiles; t += nb) conv_tile(src, K, N, dst, t, ldsf, tid);
}

struct Epi {
    int mode;
    bf16_t* dst; int ld; int s0;
    const float* gain; const float* ssq; const float* cbias;
    int pos_mul, pos_add;
    float* kmp; int vtS;
    const float* xold; float* xnew; bf16_t* anext; const float* gnext; float* ssq_out;
    const float* rope;
    float* p32;
};

DI void epilogue(const Epi& e, const float* C, float* red, const float* rsd, int tid) {
    const int l16 = tid & 15, rg = tid >> 4;
    if (e.mode == 2) {
        const int r8 = tid & 15, cgp = tid >> 4;
        float rs[8];
#pragma unroll
        for (int j = 0; j < 8; ++j) rs[j] = e.ssq ? rsd[r8 * 8 + j] : 1.f;
#pragma unroll 2
        for (int pass = 0; pass < 8; ++pass) {
            const int col = pass * 16 + cgp;
            const float bias = e.cbias ? e.cbias[col] : 0.f;
            float v[8];
#pragma unroll
            for (int j = 0; j < 8; ++j) v[j] = C[(r8 * 8 + j) * 132 + col] * rs[j] + bias;
            uint4 w; w.x = cvtpk(v[0], v[1]); w.y = cvtpk(v[2], v[3]); w.z = cvtpk(v[4], v[5]); w.w = cvtpk(v[6], v[7]);
            { const int sv = e.s0 + r8 * 8; *(uint4*)(e.dst + ((size_t)(sv >> 6) * 128 + col) * 64 + (sv & 63)) = w; }
        }
        return;
    }
    if (e.mode == 4) {
#pragma unroll 4
        for (int it = 0; it < 8; ++it) {
            const int row = it * 16 + rg;
            *(float4*)(e.p32 + (size_t)row * 128 + 4 * l16) = *(const float4*)(C + row * 132 + 4 * l16);
            *(float4*)(e.p32 + (size_t)row * 128 + 64 + 4 * l16) = *(const float4*)(C + row * 132 + 64 + 4 * l16);
        }
        return;
    }
    if (e.mode == 3) {
#pragma unroll 4
        for (int it = 0; it < 8; ++it) {
            const int row = it * 16 + rg;
            const float4 c0 = *(const float4*)(C + row * 132 + 4 * l16), c1 = *(const float4*)(C + row * 132 + 64 + 4 * l16);
            const float4 x0 = *(const float4*)(e.xold + (size_t)row * DM + 4 * l16), x1 = *(const float4*)(e.xold + (size_t)row * DM + 64 + 4 * l16);
            float4 n0, n1;
            n0.x = x0.x + c0.x; n0.y = x0.y + c0.y; n0.z = x0.z + c0.z; n0.w = x0.w + c0.w;
            n1.x = x1.x + c1.x; n1.y = x1.y + c1.y; n1.z = x1.z + c1.z; n1.w = x1.w + c1.w;
            *(float4*)(e.xnew + (size_t)row * DM + 4 * l16) = n0;
            *(float4*)(e.xnew + (size_t)row * DM + 64 + 4 * l16) = n1;
            if (e.anext) {
                float ss = n0.x * n0.x + n0.y * n0.y + n0.z * n0.z + n0.w * n0.w + n1.x * n1.x + n1.y * n1.y + n1.z * n1.z + n1.w * n1.w;
                ss += __shfl_xor(ss, 8); ss += __shfl_xor(ss, 4); ss += __shfl_xor(ss, 2); ss += __shfl_xor(ss, 1);
                if (l16 == 0) e.ssq_out[row] = ss;
                const float4 g0 = *(const float4*)(e.gnext + 4 * l16), g1 = *(const float4*)(e.gnext + 64 + 4 * l16);
                uint2 w0, w1;
                w0.x = cvtpk(n0.x * g0.x, n0.y * g0.y); w0.y = cvtpk(n0.z * g0.z, n0.w * g0.w);
                w1.x = cvtpk(n1.x * g1.x, n1.y * g1.y); w1.y = cvtpk(n1.z * g1.z, n1.w * g1.w);
                *(uint2*)(e.anext + (size_t)row * DM + 4 * l16) = w0;
                *(uint2*)(e.anext + (size_t)row * DM + 64 + 4 * l16) = w1;
            }
        }
        return;
    }
    float cs[8];
#pragma unroll
    for (int j = 0; j < 8; ++j) cs[j] = 0.f;
    float bia[8];
#pragma unroll
    for (int j = 0; j < 4; ++j) { bia[j] = e.cbias ? e.cbias[4 * l16 + j] : 0.f; bia[4 + j] = e.cbias ? e.cbias[64 + 4 * l16 + j] : 0.f; }
#pragma unroll 4
    for (int it = 0; it < 8; ++it) {
        const int row = it * 16 + rg;
        const float rs = e.ssq ? rsd[row] : 1.f;
        const float4 c0 = *(const float4*)(C + row * 132 + 4 * l16), c1 = *(const float4*)(C + row * 132 + 64 + 4 * l16);
        float v[8] = {c0.x * rs + bia[0], c0.y * rs + bia[1], c0.z * rs + bia[2], c0.w * rs + bia[3],
                      c1.x * rs + bia[4], c1.y * rs + bia[5], c1.z * rs + bia[6], c1.w * rs + bia[7]};
        if (e.mode == 1) {
            float ss = 0.f;
#pragma unroll
            for (int j = 0; j < 8; ++j) ss += v[j] * v[j];
            ss += __shfl_xor(ss, 8); ss += __shfl_xor(ss, 4); ss += __shfl_xor(ss, 2); ss += __shfl_xor(ss, 1);
            const float inv = rsqrtf(ss * (1.f / 128.f) + EPS);
            const float4 g0 = *(const float4*)(e.gain + 4 * l16), g1 = *(const float4*)(e.gain + 64 + 4 * l16);
            v[0] *= inv * g0.x; v[1] *= inv * g0.y; v[2] *= inv * g0.z; v[3] *= inv * g0.w;
            v[4] *= inv * g1.x; v[5] *= inv * g1.y; v[6] *= inv * g1.z; v[7] *= inv * g1.w;
            int pos = (e.s0 + row) * e.pos_mul + e.pos_add;
            pos = pos > 4095 ? 4095 : pos;
            const float4 cc = *(const float4*)(e.rope + pos * 64 + 4 * l16), sn = *(const float4*)(e.rope + 262144 + pos * 64 + 4 * l16);
            const float a0 = v[0] * cc.x - v[4] * sn.x, b0 = v[4] * cc.x + v[0] * sn.x;
            const float a1 = v[1] * cc.y - v[5] * sn.y, b1 = v[5] * cc.y + v[1] * sn.y;
            const float a2 = v[2] * cc.z - v[6] * sn.z, b2 = v[6] * cc.z + v[2] * sn.z;
            const float a3 = v[3] * cc.w - v[7] * sn.w, b3 = v[7] * cc.w + v[3] * sn.w;
            v[0] = a0; v[1] = a1; v[2] = a2; v[3] = a3; v[4] = b0; v[5] = b1; v[6] = b2; v[7] = b3;
#pragma unroll
            for (int j = 0; j < 8; ++j) cs[j] += v[j];
        }
        uint2 w0, w1;
        w0.x = cvtpk(v[0], v[1]); w0.y = cvtpk(v[2], v[3]); w1.x = cvtpk(v[4], v[5]); w1.y = cvtpk(v[6], v[7]);
        bf16_t* d = e.dst + (size_t)(e.s0 + row) * e.ld;
        *(uint2*)(d + 4 * l16) = w0;
        *(uint2*)(d + 64 + 4 * l16) = w1;
    }
    if (e.kmp) {
        const int lane = tid & 63, wave = tid >> 6;
#pragma unroll
        for (int j = 0; j < 8; ++j) { cs[j] += __shfl_xor(cs[j], 16); cs[j] += __shfl_xor(cs[j], 32); }
        if (lane < 16) {
#pragma unroll
            for (int j = 0; j < 4; ++j) { red[wave * 128 + 4 * lane + j] = cs[j]; red[wave * 128 + 64 + 4 * lane + j] = cs[4 + j]; }
        }
        __syncthreads();
        if (tid < 128) e.kmp[tid] = red[tid] + red[128 + tid] + red[256 + tid] + red[384 + tid];
    }
}

DI void gemm_tile(const bf16_t* __restrict__ A, int lda, const bf16_t* __restrict__ Bt, int ldb, int K,
                  unsigned char* smem, const Epi& e0, int tid) {
    asm volatile("" : "+v"(tid));
    bf16_t* As = (bf16_t*)smem;
    bf16_t* Bs = As + 256 * 72;
    const int lane = tid & 63, wave = tid >> 6, r = lane & 31, h = lane >> 5;
    const int wm = (wave >> 1) * 128, wn = (wave & 1) * 64;
    const int lrow = tid >> 3, lkc = (tid & 7) * 8;
    const bf16_t* ag = A + (size_t)lrow * lda + lkc;
    const bf16_t* bg = Bt + (size_t)lrow * ldb + lkc;
    u32x4v ra[8], rb[4];
    f32x16 acc[4][2];
#pragma unroll
    for (int i = 0; i < 4; ++i)
#pragma unroll
        for (int j = 0; j < 2; ++j)
#pragma unroll
            for (int q = 0; q < 16; ++q) acc[i][j][q] = 0.f;
#define GLA(i_, k0) { ra[i_] = *(const u32x4v*)(ag + (size_t)(32 * i_) * lda + (k0)); }
#define GLB(i_, k0) { rb[i_] = *(const u32x4v*)(bg + (size_t)(32 * i_) * ldb + (k0)); }
#define GL(k0) { GLA(0, k0) GLA(1, k0) GLA(2, k0) GLA(3, k0) GLA(4, k0) GLA(5, k0) GLA(6, k0) GLA(7, k0) GLB(0, k0) GLB(1, k0) GLB(2, k0) GLB(3, k0) }
#define LSA(i_) { *(u32x4v*)(As + (lrow + 32 * i_) * 72 + lkc) = ra[i_]; }
#define LSB(i_) { *(u32x4v*)(Bs + (lrow + 32 * i_) * 72 + lkc) = rb[i_]; }
#define LS() { LSA(0) LSA(1) LSA(2) LSA(3) LSA(4) LSA(5) LSA(6) LSA(7) LSB(0) LSB(1) LSB(2) LSB(3) }
#define LDA01(ks) { fa[0] = *(const bf16x8*)(As + (wm + r) * 72 + h * 8 + (ks) * 16); fa[1] = *(const bf16x8*)(As + (wm + 32 + r) * 72 + h * 8 + (ks) * 16); }
#define LDA23(ks) { fa[2] = *(const bf16x8*)(As + (wm + 64 + r) * 72 + h * 8 + (ks) * 16); fa[3] = *(const bf16x8*)(As + (wm + 96 + r) * 72 + h * 8 + (ks) * 16); }
#define LDB(ks, s_) { fb[s_][0] = *(const bf16x8*)(Bs + (wn + r) * 72 + h * 8 + (ks) * 16); fb[s_][1] = *(const bf16x8*)(Bs + (wn + 32 + r) * 72 + h * 8 + (ks) * 16); }
#define MM01(s_) { acc[0][0] = MFMA(fa[0], fb[s_][0], acc[0][0]); acc[0][1] = MFMA(fa[0], fb[s_][1], acc[0][1]); acc[1][0] = MFMA(fa[1], fb[s_][0], acc[1][0]); acc[1][1] = MFMA(fa[1], fb[s_][1], acc[1][1]); }
#define MM23(s_) { acc[2][0] = MFMA(fa[2], fb[s_][0], acc[2][0]); acc[2][1] = MFMA(fa[2], fb[s_][1], acc[2][1]); acc[3][0] = MFMA(fa[3], fb[s_][0], acc[3][0]); acc[3][1] = MFMA(fa[3], fb[s_][1], acc[3][1]); }
#define SBAR __builtin_amdgcn_sched_barrier(0);
#define KSTEP(ks, s_, last) { LDA23(ks) SBAR MM01(s_) SBAR if (!(last)) { LDA01((ks) + 1) LDB((ks) + 1, (s_) ^ 1) } SBAR MM23(s_) SBAR }
#define KSTEP0(ks, s_) { MM01(s_) SBAR LDA01((ks) + 1) LDB((ks) + 1, (s_) ^ 1) SBAR MM23(s_) SBAR }
    bf16x8 fa[4], fb[2][2];
    const int nk = K >> 6;
    if (e0.ssq) {
        float ssum = 0.f;
#pragma unroll
        for (int pp = 0; pp < 16; ++pp) ssum += e0.ssq[pp * NTOK + tid];
        ((float*)(smem + LDS_RSD))[tid] = rsqrtf(ssum * (1.f / 2048.f) + EPS);
    }
    GL(0);
    for (int kt = 0; kt < nk; ++kt) {
        LS();
        __syncthreads();
        LDA01(0) LDB(0, 0) LDA23(0) SBAR
        if (kt + 1 < nk) { GL((kt + 1) * 64); }
        SBAR KSTEP0(0, 0) KSTEP(1, 1, false) KSTEP(2, 0, false) KSTEP(3, 1, true)
        __syncthreads();
    }
#undef GL
#undef LS
#undef GLA
#undef GLB
#undef LSA
#undef LSB
#undef LDA01
#undef LDA23
#undef LDB
#undef MM01
#undef MM23
#undef SBAR
#undef KSTEP
#undef KSTEP0
    float* C = (float*)smem;
    float* red = (float*)(smem + LDS_RED);
    float* rsd = (float*)(smem + LDS_RSD);
#pragma unroll
    for (int half = 0; half < 2; ++half) {
        Epi e = e0;
        if (half) {
            e.s0 += 128;
            if (e.ssq) e.ssq += 128;
            if (e.kmp) e.kmp += 128;
            if (e.xold) { e.xold += (size_t)128 * DM; e.xnew += (size_t)128 * DM; }
            if (e.anext) { e.anext += (size_t)128 * DM; e.ssq_out += 128; }
            if (e.p32) e.p32 += 128 * 128;
        }
        if ((wave >> 1) == half) {
#pragma unroll
            for (int i = 0; i < 4; ++i)
#pragma unroll
                for (int j = 0; j < 2; ++j)
#pragma unroll
                    for (int q = 0; q < 16; ++q) C[(32 * i + crow(q, h)) * 132 + wn + 32 * j + r] = acc[i][j][q];
        }
        __syncthreads();
        epilogue(e, C, red, rsd + half * 128, tid);
        __syncthreads();
    }
}

DI void reduce_tile(const float* __restrict__ P, int nparts, size_t pstride, unsigned char* smem, const Epi& e0, int tid) {
    asm volatile("" : "+v"(tid));
    float* C = (float*)smem;
    float* red = (float*)(smem + LDS_RED);
    float* rsd = (float*)(smem + LDS_RSD);
    for (int half = 0; half < 2; ++half) {
        Epi e = e0;
        if (half) e.s0 += 128;
        for (int c = tid; c < 128 * 32; c += 256) {
            const int row = c >> 5, c4 = (c & 31) * 4;
            float4 a = make_float4(0.f, 0.f, 0.f, 0.f);
            for (int pp = 0; pp < nparts; ++pp) {
                const float4 v = *(const float4*)(P + (size_t)pp * pstride + (size_t)(half * 128 + row) * 128 + c4);
                a.x += v.x; a.y += v.y; a.z += v.z; a.w += v.w;
            }
            *(float4*)(C + row * 132 + c4) = a;
        }
        __syncthreads();
        epilogue(e, C, red, rsd, tid);
        __syncthreads();
    }
}

enum { K_MOBA = 0, K_SB = 1, K_CMP = 2, K_SLC = 3, K_WIN = 4 };
enum { M_SOFT = 0, M_SB = 1, M_CMP1 = 2, M_CMP2 = 3 };

template <int KIND> DI int seq_next(int t, unsigned long long U) {
    if (KIND == K_SB) return t - 1;
    if (KIND == K_SLC) { ++t; while (t < 64 && !((U >> t) & 1ull)) ++t; return t; }
    return t + 1;
}

DI void qk_block(const bf16x8 (&qf)[8], const bf16_t* Ks, int kb, int r, int h, f32x16& s) {
#pragma unroll
    for (int q = 0; q < 16; ++q) s[q] = 0.f;
    const bf16_t* kp = Ks + (kb * 32 + r) * 136 + h * 8;
#pragma unroll
    for (int st = 0; st < 8; ++st) {
        const bf16x8 a = *(const bf16x8*)(kp + st * 16);
        s = MFMA(a, qf[st], s);
        if (st == 3) __builtin_amdgcn_sched_barrier(0);
    }
}
DI void pv_block(f32x16 (&o)[4], const f32x16& p, const bf16_t* Vs, int kb, int r, int h) {
#pragma unroll
    for (int s2 = 0; s2 < 2; ++s2) {
        u32x4v pw;
        pw[0] = cvtpk(p[8 * s2 + 0], p[8 * s2 + 1]); pw[1] = cvtpk(p[8 * s2 + 2], p[8 * s2 + 3]);
        pw[2] = cvtpk(p[8 * s2 + 4], p[8 * s2 + 5]); pw[3] = cvtpk(p[8 * s2 + 6], p[8 * s2 + 7]);
        const bf16x8 pb = __builtin_bit_cast(bf16x8, pw);
#pragma unroll
        for (int db = 0; db < 4; ++db) {
            const bf16_t* vp = Vs + (db * 32 + r) * 68 + kb * 32 + s2 * 16 + 4 * h;
            const uint2 lo = *(const uint2*)vp, hi = *(const uint2*)(vp + 8);
            u32x4v aw; aw[0] = lo.x; aw[1] = lo.y; aw[2] = hi.x; aw[3] = hi.y;
            o[db] = MFMA(__builtin_bit_cast(bf16x8, aw), pb, o[db]);
        }
    }
}

DI void sb_block(f32x16& s, int keyb, int h, int khi, float& carry) {
    float lk[16];
#pragma unroll
    for (int i = 0; i < 16; ++i) {
        const float z = s[i] * SCALE;
        const bool valid = (keyb + crow(i, h)) <= khi;
        const float ls = fminf(z, 0.f) - __logf(1.f + __expf(-fabsf(z)));
        lk[i] = valid ? (ls - z) : 0.f;
        s[i] = valid ? ls : -3e38f;
    }
    float g[4], pg[4], aft[4];
#pragma unroll
    for (int a = 0; a < 4; ++a) { g[a] = (lk[4 * a] + lk[4 * a + 1]) + (lk[4 * a + 2] + lk[4 * a + 3]); pg[a] = __shfl_xor(g[a], 32); }
    float run = 0.f;
#pragma unroll
    for (int a = 3; a >= 0; --a) { aft[a] = run + (h == 0 ? pg[a] : 0.f); run += g[a] + pg[a]; }
#pragma unroll
    for (int a = 0; a < 4; ++a) {
        float within = 0.f;
#pragma unroll
        for (int b = 3; b >= 0; --b) {
            const float la = carry + aft[a] + within;
            const float ls = s[4 * a + b];
            s[4 * a + b] = (ls > -1e38f) ? __expf(ls + la) : 0.f;
            within += lk[4 * a + b];
        }
    }
    carry += run;
}

template <int KIND, int MODE>
DI void flash(unsigned char* smem, const bf16_t* __restrict__ Kp, int ldk, const bf16_t* __restrict__ Vp, int ldv, int first, int nt,
              unsigned long long U, const bf16x8 (&qf)[8], f32x16 (&o)[4], float& m, float& l, int t, int cur, unsigned long long sel,
              float inv_l, float* imp, int tid) {
    const int lane = tid & 63, wave = tid >> 6, r = lane & 31, h = lane >> 5;
    u32x4v rk[4], rv[4];
#define GLT1(i_, key0_) { const int c_ = tid + 256 * i_; \
        rk[i_] = *(const u32x4v*)(Kp + (size_t)((key0_) + (c_ >> 4)) * ldk + (c_ & 15) * 8); \
        rv[i_] = *(const u32x4v*)(Vp + (size_t)(key0_) * 128 + (c_ >> 3) * 64 + (c_ & 7) * 8); }
#define GLT(tile) { const int k0__ = (tile) * 64; GLT1(0, k0__) GLT1(1, k0__) GLT1(2, k0__) GLT1(3, k0__) }
#define LST1(i_, ks_, vs_) { const int c_ = tid + 256 * i_; \
        *(u32x4v*)(ks_ + (c_ >> 4) * 136 + (c_ & 15) * 8) = rk[i_]; \
        uint2* vd_ = (uint2*)(vs_ + (c_ >> 3) * 68 + (c_ & 7) * 8); vd_[0] = make_uint2(rv[i_][0], rv[i_][1]); vd_[1] = make_uint2(rv[i_][2], rv[i_][3]); }
#define LST(buf) { bf16_t* ks__ = (bf16_t*)(smem + (buf) * 34816); bf16_t* vs__ = ks__ + 64 * 136; LST1(0, ks__, vs__) LST1(1, ks__, vs__) LST1(2, ks__, vs__) LST1(3, ks__, vs__) }
    int tf = first;
    GLT(tf);
    LST(0);
    if (nt > 1) { tf = seq_next<KIND>(tf, U); GLT(tf); }
    __syncthreads();
    int tc = first;
    for (int it = 0; it < nt; ++it) {
        const int buf = it & 1;
        if (it + 1 < nt) { LST(buf ^ 1); }
        if (it + 2 < nt) { tf = seq_next<KIND>(tf, U); GLT(tf); }
        const bf16_t* Ks = (const bf16_t*)(smem + buf * 34816);
        const bf16_t* Vs = Ks + 64 * 136;
        bool lsel = true; int klo = 0, khi = 0;
        if (KIND == K_MOBA) { const int blk = tc >> 2; if (blk < cur) { lsel = (sel >> blk) & 1ull; khi = 1 << 30; } else { khi = t; } }
        else if (KIND == K_SB) { khi = t - 1; }
        else if (KIND == K_CMP) { khi = (t - 31) >> 4; }
        else if (KIND == K_SLC) { lsel = (sel >> tc) & 1ull; khi = t; }
        else { klo = t - 511; khi = t; }
        const int key0 = tc * 64;
        const bool act = lsel && (key0 <= khi) && (key0 + 63 >= klo) && (KIND != K_SB || l > -110.f);
        const bool wact = (KIND == K_CMP) ? true : (__ballot(act) != 0ull);
        if (wact) {
#pragma unroll
            for (int kk = 0; kk < 2; ++kk) {
                const int kb = (MODE == M_SB) ? 1 - kk : kk;
                const int keyb = key0 + 32 * kb;
                const bool bact = (KIND == K_CMP) ? true : (__ballot(act && (keyb <= khi) && (keyb + 31 >= klo)) != 0ull);
                if (bact) {
                    f32x16 s;
                    qk_block(qf, Ks, kb, r, h, s);
                    if (MODE == M_SB) {
                        sb_block(s, keyb, h, khi, l);
                        pv_block(o, s, Vs, kb, r, h);
                    } else if (MODE == M_CMP2) {
#pragma unroll
                        for (int i = 0; i < 16; ++i) s[i] = (keyb + crow(i, h) <= khi) ? __expf(s[i] * SCALE - m) * inv_l : 0.f;
                        pv_block(o, s, Vs, kb, r, h);
                        float gs_[4], p3_[4];
#pragma unroll
                        for (int a = 0; a < 4; ++a) { gs_[a] = (s[4 * a] + s[4 * a + 1]) + (s[4 * a + 2] + s[4 * a + 3]); p3_[a] = s[4 * a + 3]; }
                        for (int w = 0; w < 4; ++w) {
                            if (wave == w) {
#pragma unroll
                                for (int a = 0; a < 4; ++a) {
                                    const int j = 16 * tc + 8 * kb + 2 * a + h;
                                    imp[j * 32 + r] += gs_[a];
                                    if (j + 1 < 64) imp[(j + 1) * 32 + r] += p3_[a];
                                }
                            }
                            __syncthreads();
                        }
                    } else {
                        const bool lall = lsel && (keyb >= klo) && (keyb + 31 <= khi);
                        const bool lnone = !(lsel && (keyb <= khi) && (keyb + 31 >= klo));
                        float mnew, alpha, rs = 0.f;
                        if (__ballot(!(lall || lnone)) == 0ull) {
                            constexpr float CL2 = SCALE * 1.4426950408889634f;
                            float mx = s[0];
#pragma unroll
                            for (int i = 1; i < 16; ++i) mx = fmaxf(mx, s[i]);
                            mx = lall ? mx * SCALE : NEGF;
                            mx = fmaxf(mx, __shfl_xor(mx, 32));
                            const bool grow = mx > m + 8.f;
                            mnew = grow ? mx : m;
                            alpha = 1.f;
                            if (__ballot(grow) != 0ull) alpha = grow ? __expf(m - mnew) : 1.f;
                            const float mexp = lall ? mnew * 1.4426950408889634f : 3e38f;
#pragma unroll
                            for (int i = 0; i < 16; ++i) s[i] = __builtin_amdgcn_exp2f(__builtin_fmaf(s[i], CL2, -mexp));
#pragma unroll
                            for (int i = 0; i < 16; ++i) rs += s[i];
                        } else {
                            float mx = NEGF;
#pragma unroll
                            for (int i = 0; i < 16; ++i) {
                                const int k_ = keyb + crow(i, h);
                                const bool v_ = lsel && (k_ >= klo) && (k_ <= khi);
                                s[i] = v_ ? s[i] * SCALE : NEGF;
                                mx = fmaxf(mx, s[i]);
                            }
                            mx = fmaxf(mx, __shfl_xor(mx, 32));
                            const bool grow = mx > m + 8.f;
                            mnew = grow ? mx : m;
                            alpha = grow ? __expf(m - mnew) : 1.f;
#pragma unroll
                            for (int i = 0; i < 16; ++i) {
                                const float p_ = (s[i] > -5e29f) ? __expf(s[i] - mnew) : 0.f;
                                s[i] = p_; rs += p_;
                            }
                        }
                        rs += __shfl_xor(rs, 32);
                        l = l * alpha + rs;
                        if (MODE == M_SOFT) {
                            if (__ballot(mnew > m) != 0ull) {
#pragma unroll
                                for (int db = 0; db < 4; ++db)
#pragma unroll
                                    for (int q = 0; q < 16; ++q) o[db][q] *= alpha;
                            }
                            pv_block(o, s, Vs, kb, r, h);
                        }
                        m = mnew;
                    }
                }
                __builtin_amdgcn_sched_barrier(0);
            }
        }
        if (KIND == K_SB) {
            volatile int* flags = (volatile int*)(smem + LDS_SELM);
            const bool wdone = __ballot((l > -110.f) && (khi >= 0)) == 0ull;
            if (wdone && lane == 0) flags[wave] = 1;
            __syncthreads();
            if (flags[0] & flags[1] & flags[2] & flags[3]) break;
        } else {
            __syncthreads();
        }
        tc = seq_next<KIND>(tc, U);
    }
#undef GLT
#undef LST
#undef GLT1
#undef LST1
}

DI void load_q(bf16x8 (&qf)[8], const bf16_t* qrow, int h) {
#pragma unroll
    for (int st = 0; st < 8; ++st) qf[st] = *(const bf16x8*)(qrow + st * 16 + h * 8);
}
DI void zero_o(f32x16 (&o)[4]) {
#pragma unroll
    for (int db = 0; db < 4; ++db)
#pragma unroll
        for (int q = 0; q < 16; ++q) o[db][q] = 0.f;
}
DI void write_y(const f32x16 (&o)[4], float sc, const bf16_t* acc1, const bf16_t* acc2, const bf16_t* grow, bf16_t* yrow, int h) {
#pragma unroll
    for (int db = 0; db < 4; ++db)
#pragma unroll
        for (int a = 0; a < 4; ++a) {
            const int d = 32 * db + 8 * a + 4 * h;
            float v0 = o[db][4 * a] * sc, v1 = o[db][4 * a + 1] * sc, v2 = o[db][4 * a + 2] * sc, v3 = o[db][4 * a + 3] * sc;
            if (acc1) { const uint2 b1 = *(const uint2*)(acc1 + d), b2 = *(const uint2*)(acc2 + d);
                v0 += bflo(b1.x) + bflo(b2.x); v1 += bfhi(b1.x) + bfhi(b2.x); v2 += bflo(b1.y) + bflo(b2.y); v3 += bfhi(b1.y) + bfhi(b2.y); }
            const uint2 gg = *(const uint2*)(grow + d);
            const float g0 = bflo(gg.x), g1 = bfhi(gg.x), g2 = bflo(gg.y), g3 = bfhi(gg.y);
            uint2 w;
            w.x = cvtpk(v0 * g0 * sigmoidf_(g0), v1 * g1 * sigmoidf_(g1));
            w.y = cvtpk(v2 * g2 * sigmoidf_(g2), v3 * g3 * sigmoidf_(g3));
            *(uint2*)(yrow + d) = w;
            if (a == 3) __builtin_amdgcn_sched_barrier(0);
        }
}
DI void acc_store(const f32x16 (&o)[4], float sc, bf16_t* accrow, int h) {
#pragma unroll
    for (int db = 0; db < 4; ++db)
#pragma unroll
        for (int a = 0; a < 4; ++a) {
            const int d = 32 * db + 8 * a + 4 * h;
            uint2 w;
            w.x = cvtpk(o[db][4 * a] * sc, o[db][4 * a + 1] * sc);
            w.y = cvtpk(o[db][4 * a + 2] * sc, o[db][4 * a + 3] * sc);
            *(uint2*)(accrow + d) = w;
        }
}

DI const float* sel4(int i, const float* a, const float* b, const float* c, const float* d) { return i == 0 ? a : (i == 1 ? b : (i == 2 ? c : d)); }
DI bool panel_tile(int i, int bid, int nb, int NT, int PW, int& mt, int& nt) {
    if (nb & 7) { const int tI = bid + i * nb; if (tI >= 32 * NT) return false; mt = tI / NT; nt = tI - mt * NT; return true; }
    const int x = bid & 7, nl = nb >> 3, NP = (NT + PW - 1) / PW;
    int u = (bid >> 3) + i * nl;
    for (int p = x; p < NP; p += 8) {
        const int w = (NT - p * PW) < PW ? (NT - p * PW) : PW;
        const int cnt = 32 * w;
        if (u < cnt) { mt = u / w; nt = p * PW + (u - mt * w); return true; }
        u -= cnt;
    }
    return false;
}
DI int snake(int rd, int bid, int nb) { return rd * nb + ((rd & 1) ? (nb - 1 - bid) : bid); }

DI void moba_item(unsigned char* ws, unsigned char* smem, int idx, int tid) {
    asm volatile("" : "+v"(tid));
    const int lane = tid & 63, wave = tid >> 6, r = lane & 31, h = lane >> 5;
    const int qt = 31 - (idx >> 5), bh = idx & 31, b = bh >> 4, head = bh & 15;
    const int q0 = qt * 128, cur = q0 >> 8;
    const int t = q0 + 32 * wave + r;
    bf16_t* Q = (bf16_t*)(ws + WS_Q);
    const bf16_t* Kb = (const bf16_t*)(ws + WS_K) + (size_t)bh * SEQ * 128;
    const bf16_t* Vt = (const bf16_t*)(ws + WS_VT) + (size_t)bh * 128 * SEQ;
    const bf16_t* G = (const bf16_t*)(ws + WS_G);
    const float* kmp = (const float*)(ws + WS_KMP) + (size_t)bh * 32 * 128;
    const size_t rowoff = (size_t)(b * SEQ + t) * DM + head * 128;
    bf16x8 qf[8];
    load_q(qf, Q + rowoff, h);
    unsigned long long sel = 0ull;
    if (cur > 0) {
        f32x16 gacc;
#pragma unroll
        for (int q = 0; q < 16; ++q) gacc[q] = 0.f;
        const bool vrow = r < cur;
        const float* k0p = kmp + (size_t)(2 * r) * 128 + h * 8;
#pragma unroll
        for (int st = 0; st < 8; ++st) {
            float km[8];
#pragma unroll
            for (int j = 0; j < 8; ++j) km[j] = 0.f;
            if (vrow) {
                const float4 a0 = *(const float4*)(k0p + st * 16), a1 = *(const float4*)(k0p + st * 16 + 4);
                const float4 c0 = *(const float4*)(k0p + 128 + st * 16), c1 = *(const float4*)(k0p + 128 + st * 16 + 4);
                km[0] = (a0.x + c0.x) * (1.f / 256.f); km[1] = (a0.y + c0.y) * (1.f / 256.f); km[2] = (a0.z + c0.z) * (1.f / 256.f); km[3] = (a0.w + c0.w) * (1.f / 256.f);
                km[4] = (a1.x + c1.x) * (1.f / 256.f); km[5] = (a1.y + c1.y) * (1.f / 256.f); km[6] = (a1.z + c1.z) * (1.f / 256.f); km[7] = (a1.w + c1.w) * (1.f / 256.f);
            }
            u32x4v hi, lo;
#pragma unroll
            for (int j = 0; j < 4; ++j) {
                const unsigned hw = cvtpk(km[2 * j], km[2 * j + 1]);
                hi[j] = hw;
                lo[j] = cvtpk(km[2 * j] - bflo(hw), km[2 * j + 1] - bfhi(hw));
            }
            gacc = MFMA(__builtin_bit_cast(bf16x8, hi), qf[st], gacc);
            gacc = MFMA(__builtin_bit_cast(bf16x8, lo), qf[st], gacc);
        }
        float gv[16];
#pragma unroll
        for (int a = 0; a < 2; ++a)
#pragma unroll
            for (int bb = 0; bb < 4; ++bb) {
                const float own = gacc[4 * a + bb];
                const float oth = __shfl_xor(own, 32);
                gv[8 * a + bb] = (h == 0) ? own : oth;
                gv[8 * a + 4 + bb] = (h == 0) ? oth : own;
            }
        unsigned smask = 0u;
#pragma unroll
        for (int k = 0; k < 3; ++k) {
            float bv = -3e38f; int bi = -1;
#pragma unroll
            for (int n = 0; n < 16; ++n) {
                const bool ok = (n < cur) && !((smask >> n) & 1u) && (gv[n] > bv);
                bv = ok ? gv[n] : bv; bi = ok ? n : bi;
            }
            if (bi >= 0) smask |= 1u << bi;
        }
        sel = smask;
    }
    f32x16 o[4];
    zero_o(o);
    float m = NEGF, l = 0.f;
    const int nt = (q0 + 128) >> 6;
    flash<K_MOBA, M_SOFT>(smem, Kb, 128, Vt, SEQ, 0, nt, 0ull, qf, o, m, l, t, cur, sel, 0.f, nullptr, tid);
    write_y(o, 1.f / l, nullptr, nullptr, G + rowoff, Q + rowoff, h);
}

DI void sb_item(unsigned char* ws, unsigned char* smem, int idx, int tid) {
    asm volatile("" : "+v"(tid));
    const int lane = tid & 63, wave = tid >> 6, r = lane & 31, h = lane >> 5;
    const int qt = 31 - (idx >> 5), bh = idx & 31, b = bh >> 4, head = bh & 15;
    const int q0 = qt * 128;
    const int t = q0 + 32 * wave + r;
    bf16_t* Q = (bf16_t*)(ws + WS_Q);
    const bf16_t* Kb = (const bf16_t*)(ws + WS_K) + (size_t)bh * SEQ * 128;
    const bf16_t* Vt = (const bf16_t*)(ws + WS_VT) + (size_t)bh * 128 * SEQ;
    const bf16_t* G = (const bf16_t*)(ws + WS_G);
    const size_t rowoff = (size_t)(b * SEQ + t) * DM + head * 128;
    bf16x8 qf[8];
    load_q(qf, Q + rowoff, h);
    f32x16 o[4];
    zero_o(o);
    float m = 0.f, carry = 0.f;
    const int nt = (q0 + 128) >> 6;
    __syncthreads();
    if (tid < 4) ((volatile int*)(smem + LDS_SELM))[tid] = 0;
    flash<K_SB, M_SB>(smem, Kb, 128, Vt, SEQ, nt - 1, nt, 0ull, qf, o, m, carry, t, 0, 0ull, 0.f, nullptr, tid);
    write_y(o, 1.f, nullptr, nullptr, G + rowoff, Q + rowoff, h);
}

DI void nsa_item(unsigned char* ws, unsigned char* smem, int idx, int tid) {
    asm volatile("" : "+v"(tid));
    const int lane = tid & 63, wave = tid >> 6, r = lane & 31, h = lane >> 5;
    const int c = 127 - (idx >> 3), bg = idx & 7, b = bg >> 2, g = bg & 3;
    const int head = g * 4 + wave;
    const int q0 = c * 32, t = q0 + r, cur = q0 >> 6;
    bf16_t* Q = (bf16_t*)(ws + WS_Q);
    const bf16_t* G = (const bf16_t*)(ws + WS_G);
    const bf16_t* KS = (const bf16_t*)(ws + WS_K + 16 * MB) + (size_t)bg * SEQ * 128;
    const bf16_t* KW = (const bf16_t*)(ws + WS_K + 24 * MB) + (size_t)bg * SEQ * 128;
    const bf16_t* VST = (const bf16_t*)(ws + WS_VT) + (size_t)bg * 128 * SEQ;
    const bf16_t* VWT = (const bf16_t*)(ws + WS_VT + 8 * MB) + (size_t)bg * 128 * SEQ;
    const bf16_t* KCC = (const bf16_t*)(ws + WS_VT + 16 * MB) + (size_t)bg * 256 * 128;
    const bf16_t* VCCT = (const bf16_t*)(ws + WS_VT + 17 * MB) + (size_t)bg * 128 * 256;
    const bf16_t* BG = (const bf16_t*)(ws + WS_VT + 18 * MB);
    float* imp = (float*)(smem + LDS_IMP);
    uint2* selm = (uint2*)(smem + LDS_SELM);
    const size_t tok = (size_t)(b * SEQ + t);
    const size_t rowoff = tok * DM + head * 128;
    bf16_t* acc1 = (bf16_t*)(ws + WS_OACC) + rowoff;
    bf16_t* acc2 = (bf16_t*)(ws + WS_OACC + 32 * MB) + rowoff;
    bf16x8 qf[8];
    load_q(qf, Q + rowoff, h);
    for (int i = tid; i < 2048; i += 256) imp[i] = 0.f;
    f32x16 o[4];
    zero_o(o);
    float m = NEGF, l = 0.f;
    const int ntc = (q0 >> 10) + 1;
#ifndef X_NOCMP1
    flash<K_CMP, M_CMP1>(smem, KCC, 128, VCCT, 256, 0, ntc, 0ull, qf, o, m, l, t, cur, 0ull, 0.f, nullptr, tid);
#endif
    const float invl = 1.f / fmaxf(l, 1e-30f);
#ifndef X_NOCMP2
    flash<K_CMP, M_CMP2>(smem, KCC, 128, VCCT, 256, 0, ntc, 0ull, qf, o, m, l, t, cur, 0ull, invl, imp, tid);
#endif
    { const float g0 = sigmoidf_(__uint_as_float((unsigned)BG[tok * 128 + head] << 16)); acc_store(o, g0, acc1, h); }
#ifndef X_NOTOPK
    {
        const int q = tid >> 3, sub = tid & 7;
        float myv[8]; int rank[8];
#pragma unroll
        for (int k = 0; k < 8; ++k) {
            const int j = sub * 8 + k;
            const float v = imp[j * 32 + q];
            myv[k] = (j > cur) ? NEGF : ((j == 0 || j == cur || j == cur - 1) ? 1e30f : v);
            rank[k] = 0;
        }
        for (int jj = 0; jj < 64; ++jj) {
            float v = imp[jj * 32 + q];
            v = (jj > cur) ? NEGF : ((jj == 0 || jj == cur || jj == cur - 1) ? 1e30f : v);
#pragma unroll
            for (int k = 0; k < 8; ++k) { const int j = sub * 8 + k; rank[k] += ((v > myv[k]) || (v == myv[k] && jj < j)) ? 1 : 0; }
        }
        unsigned bits = 0u;
#pragma unroll
        for (int k = 0; k < 8; ++k) if (rank[k] < 16 && (sub * 8 + k) <= cur) bits |= 1u << k;
        unsigned lo = (sub < 4) ? (bits << (8 * sub)) : 0u, hi = (sub >= 4) ? (bits << (8 * (sub - 4))) : 0u;
        lo |= __shfl_xor(lo, 1); lo |= __shfl_xor(lo, 2); lo |= __shfl_xor(lo, 4);
        hi |= __shfl_xor(hi, 1); hi |= __shfl_xor(hi, 2); hi |= __shfl_xor(hi, 4);
        if (sub == 0) selm[q] = make_uint2(lo, hi);
    }
#endif
    __syncthreads();
    unsigned ulo = 0u, uhi = 0u;
    for (int q = 0; q < 32; ++q) { const uint2 s = selm[q]; ulo |= s.x; uhi |= s.y; }
    ulo = __builtin_amdgcn_readfirstlane(ulo); uhi = __builtin_amdgcn_readfirstlane(uhi);
    const unsigned long long U = ((unsigned long long)uhi << 32) | ulo;
    const uint2 ms = selm[r];
    const unsigned long long sel = ((unsigned long long)ms.y << 32) | ms.x;
    zero_o(o); m = NEGF; l = 0.f;
#ifndef X_NOSLC
    flash<K_SLC, M_SOFT>(smem, KS, 128, VST, SEQ, 0, __popcll(U), U, qf, o, m, l, t, cur, sel, 0.f, nullptr, tid);
#endif
    { const float g1 = sigmoidf_(__uint_as_float((unsigned)BG[tok * 128 + 16 + head] << 16)); acc_store(o, g1 / l, acc2, h); }
    zero_o(o); m = NEGF; l = 0.f;
    const int tlo = (q0 > 511 ? q0 - 511 : 0) >> 6;
#ifndef X_NOWIN
    flash<K_WIN, M_SOFT>(smem, KW, 128, VWT, SEQ, tlo, cur - tlo + 1, 0ull, qf, o, m, l, t, cur, 0ull, 0.f, nullptr, tid);
#endif
    { const float g2 = sigmoidf_(__uint_as_float((unsigned)BG[tok * 128 + 32 + head] << 16)); write_y(o, g2 / l, acc1, acc2, G + rowoff, Q + rowoff, h); }
}

#define XB_TMO      128
#define XB_XCNT(j)  (256  + 64 * (j))
#define XB_XSUB(j)  (1280 + 64 * (j))
#define XB_XGEN(j)  (2304 + 64 * (j))
#define XB_TOP      3328
#define XB_TOPGEN   3392
#define XCD_BAR_WORDS 3456
#define XB_SPIN_CAP (1u << 18)
#define LAS __attribute__((address_space(3)))
DI unsigned xb_ld(unsigned* p)              { return __hip_atomic_load(p, __ATOMIC_RELAXED, __HIP_MEMORY_SCOPE_AGENT); }
DI unsigned xb_add(unsigned* p, unsigned v) { return __hip_atomic_fetch_add(p, v, __ATOMIC_RELAXED, __HIP_MEMORY_SCOPE_AGENT); }
DI unsigned xb_xcc_id() { return (unsigned)__builtin_amdgcn_s_getreg((3 << 11) | 20) & 0xFu; }
#define XB_SPIN(cond, bar) do { unsigned _sp = 0; while (cond) { __builtin_amdgcn_s_sleep(1); \
    if ((++_sp & 255u) == 0u) { if (xb_ld(&(bar)[XB_TMO])) break; if (_sp > XB_SPIN_CAP) { atomicAdd(&(bar)[XB_TMO], 1u); break; } } } } while (0)
struct XcdBarrier { unsigned* bar; unsigned x; volatile LAS unsigned* st; };
DI XcdBarrier xcd_barrier_post(unsigned* bar, volatile LAS unsigned* st) {
    XcdBarrier b; b.bar = bar; b.x = xb_xcc_id(); b.st = st;
    if (threadIdx.x == 0) (void)xb_add(&bar[XB_XCNT(b.x)], 1u);
    return b;
}
DI void xcd_barrier_complete(unsigned* bar, unsigned x, unsigned& nloc, unsigned& nx) {
    const unsigned G = gridDim.x * gridDim.y * gridDim.z;
    unsigned sum, cnt, mine, sp = 0u;
    for (;;) {
        sum = 0u; cnt = 0u; mine = 0u;
#pragma unroll
        for (unsigned j = 0; j < 16; ++j) { const unsigned c = xb_ld(&bar[XB_XCNT(j)]); sum += c; cnt += (c > 0u) ? 1u : 0u; mine = (j == x) ? c : mine; }
        if (sum == G) break;
        __builtin_amdgcn_s_sleep(1);
        if ((++sp & 255u) == 0u) { if (xb_ld(&bar[XB_TMO])) break; if (sp > XB_SPIN_CAP) { atomicAdd(&bar[XB_TMO], 1u); break; } }
    }
    nloc = mine > 0u ? mine : 1u; nx = cnt > 0u ? cnt : 1u;
}
DI void xcd_barrier(const XcdBarrier& b) {
    asm volatile("s_waitcnt vmcnt(0)" ::: "memory");
    __syncthreads();
    if (threadIdx.x == 0) {
        unsigned* bar = b.bar;
        __builtin_amdgcn_s_waitcnt(0);
        unsigned nloc = b.st[0], nx = b.st[1];
        if (nloc == 0u) { xcd_barrier_complete(bar, b.x, nloc, nx); b.st[0] = nloc; b.st[1] = nx; }
        const unsigned old = xb_add(&bar[XB_XSUB(b.x)], 1u);
        const unsigned gen = old / nloc;
        if (old + 1u == (gen + 1u) * nloc) {
            __builtin_amdgcn_fence(__ATOMIC_RELEASE, "agent");
            asm volatile("s_waitcnt vmcnt(0)" ::: "memory");
            const unsigned og = xb_add(&bar[XB_TOP], 1u);
            const unsigned tg = og / nx;
            if (og + 1u == (tg + 1u) * nx) xb_add(&bar[XB_TOPGEN], 1u);
            else XB_SPIN(xb_ld(&bar[XB_TOPGEN]) == tg, bar);
            __builtin_amdgcn_fence(__ATOMIC_ACQUIRE, "agent");
            xb_add(&bar[XB_XGEN(b.x)], 1u);
            asm volatile("s_waitcnt vmcnt(0)" ::: "memory");
        } else {
            XB_SPIN(xb_ld(&bar[XB_XGEN(b.x)]) == gen, bar);
            __builtin_amdgcn_fence(__ATOMIC_ACQUIRE, "agent");
            asm volatile("s_waitcnt vmcnt(0)" ::: "memory");
        }
    }
    __syncthreads();
}

__global__ void __launch_bounds__(256, 2) mega(P p) {
    extern __shared__ __attribute__((aligned(16))) unsigned char smem[];
    cg::grid_group grid = cg::this_grid();
    const int tid = threadIdx.x, bid = blockIdx.x, nb = gridDim.x;
    const int lane = tid & 63, wave = tid >> 6;
    unsigned char* ws = p.ws;
    bf16_t* WIN = (bf16_t*)(ws + WS_WIN);
    bf16_t* WOUT = (bf16_t*)(ws + WS_WOUT);
    float* X = (float*)(ws + WS_X);
    bf16_t* A = (bf16_t*)(ws + WS_A);
    bf16_t* Q = (bf16_t*)(ws + WS_Q);
    bf16_t* Kb = (bf16_t*)(ws + WS_K);
    bf16_t* VT = (bf16_t*)(ws + WS_VT);
    bf16_t* G = (bf16_t*)(ws + WS_G);
    float* ROPE = (float*)(ws + WS_ROPE);
    float* SSQ = (float*)(ws + WS_SSQ);
    float* KMP = (float*)(ws + WS_KMP);
    bf16_t* CMPW = (bf16_t*)(ws + WS_CMPW);
    float* CBIAS = (float*)(ws + WS_CBIAS);
    float* ldsf = (float*)smem;
    volatile LAS unsigned* xbst = (volatile LAS unsigned*)(LAS unsigned char*)(smem) + LDS_XB / 4;
    if (tid < 4) xbst[tid] = 0u;
    __syncthreads();
    const XcdBarrier xbar = xcd_barrier_post((unsigned*)(ws + WS_BAR), xbst);
    grid.sync();

    phase_convert(p.w_in[0], DM, 8192, 8192, WIN, ldsf, tid, bid, nb);
    for (int L = 0; L < 4; ++L) phase_convert(sel4(L, p.w_out[0], p.w_out[1], p.w_out[2], p.w_out[3]), DM, DM, DM, WOUT + (size_t)L * DM * DM, ldsf, tid, bid, nb);
    phase_convert(p.cwk, 4096, 128, 128, CMPW, ldsf, tid, bid, nb);
    phase_convert(p.cwv, 4096, 128, 128, CMPW + 128 * 4096, ldsf, tid, bid, nb);
    for (int i = bid * 256 + tid; i < 4096 * 64; i += nb * 256) {
        const int pos = i >> 6, d = i & 63;
        const float inv_freq = expf(-9.210340371976184f * (float)d * (1.f / 64.f));
        const float ang = (float)pos * inv_freq;
        const double rev = (double)ang * 0.15915494309189535;
        const float fr = (float)(rev - rint(rev));
        ROPE[i] = __builtin_amdgcn_cosf(fr);
        ROPE[262144 + i] = __builtin_amdgcn_sinf(fr);
    }
    for (int cbk = bid; cbk < 64; cbk += nb) {
        const int which = tid >> 7, e = tid & 127;
        const float* W = which ? p.cwv : p.cwk;
        float s = 0.f;
#pragma unroll 8
        for (int k = cbk * 64; k < cbk * 64 + 64; ++k) s += p.cpos[k] * W[(size_t)k * 128 + e];
        CBIAS[cbk * 256 + tid] = s;
    }
    for (int row = bid * 4 + wave; row < NTOK; row += nb * 4) {
        const float4* xr = (const float4*)(p.x + (size_t)row * DM);
        const float4* gr = (const float4*)p.norm[0];
        float ss = 0.f;
#pragma unroll
        for (int i = 0; i < 8; ++i) {
            const float4 v = xr[lane + 64 * i], gg = gr[lane + 64 * i];
            ss += v.x * v.x + v.y * v.y + v.z * v.z + v.w * v.w;
            uint2 w; w.x = cvtpk(v.x * gg.x, v.y * gg.y); w.y = cvtpk(v.z * gg.z, v.w * gg.w);
            *(uint2*)(A + (size_t)row * DM + (lane + 64 * i) * 4) = w;
        }
#pragma unroll
        for (int sft = 32; sft >= 1; sft >>= 1) ss += __shfl_xor(ss, sft);
        if (lane < 16) SSQ[lane * NTOK + row] = (lane == 0) ? ss : 0.f;
    }
    xcd_barrier(xbar);

    for (int L = 0; L < 4; ++L) {
        const int kind = (L == 1) ? 1 : ((L == 2) ? 2 : 0);
        {
            const int NT = (kind == 2) ? 57 : 64;
            const float* qn = (L == 0) ? p.qn0 : ((L == 3) ? p.qn3 : p.qn2);
            const float* kn = (L == 0) ? p.kn0 : p.kn3;
            for (int it_ = 0; ; ++it_) {
                int mt, nt;
                if (!panel_tile(it_, bid, nb, NT, 8, mt, nt)) break;
                const int b = mt >> 4, s0 = (mt & 15) * 256;
                Epi e{};
                e.ssq = SSQ + mt * 256; e.s0 = s0; e.pos_mul = 1; e.pos_add = 0; e.rope = ROPE;
                if (kind != 2) {
                    const int sec = nt >> 4, hd = nt & 15;
                    if (sec == 0) { e.mode = (kind == 0) ? 1 : 0; e.dst = Q + (size_t)b * SEQ * DM + hd * 128; e.ld = DM; e.gain = qn; }
                    else if (sec == 1) { e.mode = (kind == 0) ? 1 : 0; e.dst = Kb + (size_t)(b * 16 + hd) * SEQ * 128; e.ld = 128; e.gain = kn;
                                         e.kmp = (kind == 0) ? KMP + ((size_t)(b * 16 + hd) * 32 + (mt & 15) * 2) * 128 : nullptr; }
                    else if (sec == 2) { e.mode = 2; e.dst = VT + (size_t)(b * 16 + hd) * 128 * SEQ; e.vtS = SEQ; }
                    else { e.mode = 0; e.dst = G + (size_t)b * SEQ * DM + hd * 128; e.ld = DM; }
                } else {
                    if (nt < 16) { e.mode = 1; e.dst = Q + (size_t)b * SEQ * DM + nt * 128; e.ld = DM; e.gain = qn; }
                    else if (nt < 40) {
                        const int which = (nt - 16) >> 2, gq = (nt - 16) & 3, bgi = b * 4 + gq;
                        const size_t hm = (size_t)bgi * SEQ * 128;
                        if (which == 0) { e.mode = 0; e.dst = (bf16_t*)(ws + WS_K) + hm; e.ld = 128; }
                        else if (which == 1) { e.mode = 0; e.dst = (bf16_t*)(ws + WS_K + 8 * MB) + hm; e.ld = 128; }
                        else if (which == 2) { e.mode = 1; e.dst = (bf16_t*)(ws + WS_K + 16 * MB) + hm; e.ld = 128; e.gain = p.ksn2; }
                        else if (which == 3) { e.mode = 2; e.dst = (bf16_t*)(ws + WS_VT) + hm; e.vtS = SEQ; }
                        else if (which == 4) { e.mode = 1; e.dst = (bf16_t*)(ws + WS_K + 24 * MB) + hm; e.ld = 128; e.gain = p.kwn2; }
                        else { e.mode = 2; e.dst = (bf16_t*)(ws + WS_VT + 8 * MB) + hm; e.vtS = SEQ; }
                    }
                    else if (nt < 56) { e.mode = 0; e.dst = G + (size_t)b * SEQ * DM + (nt - 40) * 128; e.ld = DM; }
                    else { e.mode = 0; e.dst = (bf16_t*)(ws + WS_VT + 18 * MB) + (size_t)b * SEQ * 128; e.ld = 128; }
                }
                gemm_tile(A + (size_t)mt * 256 * DM, DM, WIN + (size_t)nt * 128 * DM, DM, DM, smem, e, tid);
            }
        }
        xcd_barrier(xbar);
        if (kind == 2) {
            float* PART = (float*)(ws + WS_OACC);
            for (int tI = bid; tI < 128; tI += nb) {
                const int ksl = tI & 7, bgi = (tI >> 3) & 7, kv = tI >> 6;
                Epi e{};
                e.mode = 4; e.p32 = PART + (size_t)tI * 256 * 128;
                const bf16_t* Asrc = (const bf16_t*)(ws + WS_K + (size_t)kv * 8 * MB) + (size_t)bgi * SEQ * 128 + ksl * 512;
                gemm_tile(Asrc, 2048, CMPW + (size_t)kv * 128 * 4096 + ksl * 512, 4096, 512, smem, e, tid);
            }
            xcd_barrier(xbar);
            if (bid < 16) {
                float sb_ = 0.f;
                for (int i = 0; i < 64; ++i) sb_ += CBIAS[i * 256 + tid];
                ((float*)(smem + LDS_RED))[tid] = sb_;
                __syncthreads();
            }
            for (int tI = bid; tI < 16; tI += nb) {
                const int kv = tI >> 3, bgi = tI & 7;
                Epi e{};
                e.s0 = 0; e.rope = ROPE; e.cbias = (const float*)(smem + LDS_RED) + kv * 128;
                if (kv == 0) { e.mode = 1; e.gain = p.kcn2; e.dst = (bf16_t*)(ws + WS_VT + 16 * MB) + (size_t)bgi * 256 * 128; e.ld = 128; e.pos_mul = 16; e.pos_add = 31; }
                else { e.mode = 2; e.dst = (bf16_t*)(ws + WS_VT + 17 * MB) + (size_t)bgi * 128 * 256; e.vtS = 256; }
                reduce_tile(PART + (size_t)(kv * 64 + bgi * 8) * 256 * 128, 8, (size_t)256 * 128, smem, e, tid);
            }
            xcd_barrier(xbar);
        }
        for (int rd = 0; rd * nb < 1024; ++rd) {
            const int idx = snake(rd, bid, nb);
            if (idx >= 1024) continue;
#ifndef NO_MOBA
            if (kind == 0) moba_item(ws, smem, idx, tid);
#endif
#ifndef NO_SB
            if (kind == 1) sb_item(ws, smem, idx, tid);
#endif
#ifndef NO_NSA
            if (kind == 2) nsa_item(ws, smem, idx, tid);
#endif
        }
        xcd_barrier(xbar);
        for (int it_ = 0; ; ++it_) {
            int mt, nt;
            if (!panel_tile(it_, bid, nb, 16, 2, mt, nt)) break;
            Epi e{};
            e.mode = 3;
            const size_t off = (size_t)mt * 256 * DM + nt * 128;
            e.xold = ((L == 0) ? p.x : X) + off;
            e.xnew = ((L == 3) ? p.out : X) + off;
            if (L < 3) { e.anext = A + off; e.gnext = sel4(L, p.norm[1], p.norm[2], p.norm[3], p.norm[3]) + nt * 128; e.ssq_out = SSQ + (size_t)nt * NTOK + mt * 256; }
            gemm_tile(Q + (size_t)mt * 256 * DM, DM, WOUT + (size_t)L * DM * DM + (size_t)nt * 128 * DM, DM, DM, smem, e, tid);
        }
        if (L < 3) {
            const int Nn = (L + 1 == 2) ? 7216 : 8192, Np = (L + 1 == 2) ? 7296 : 8192;
            phase_convert(sel4(L, p.w_in[1], p.w_in[2], p.w_in[3], p.w_in[3]), DM, Nn, Np, WIN, ldsf, tid, bid, nb);
            xcd_barrier(xbar);
        }
    }
}

extern "C" void kernel_launch(void* const* d_in, const int* in_sizes, int n_in, void* d_out, int out_size, void* d_ws, size_t ws_size,
                              hipStream_t stream) {
    static int grid_blocks = 0;
    if (!grid_blocks) {
        if (n_in != 24 || ws_size < WS_END) { fprintf(stderr, "kernel_launch: unexpected inputs (%d) or workspace (%zu)\n", n_in, ws_size); grid_blocks = -1; return; }
        int dev = 0, cus = 0, per_cu = 0;
        (void)hipGetDevice(&dev);
        (void)hipDeviceGetAttribute(&cus, hipDeviceAttributeMultiprocessorCount, dev);
        (void)hipFuncSetAttribute((const void*)mega, hipFuncAttributeMaxDynamicSharedMemorySize, LDS_BYTES);
        (void)hipOccupancyMaxActiveBlocksPerMultiprocessor(&per_cu, (const void*)mega, 256, LDS_BYTES);
        if (per_cu < 1) per_cu = 1;
        if (per_cu > 2) per_cu = 2;
        grid_blocks = cus * per_cu;
    }
    if (grid_blocks < 0) return;
    P p{};
    p.x = (const float*)d_in[0];
    p.norm[0] = (const float*)d_in[1]; p.w_in[0] = (const float*)d_in[2]; p.qn0 = (const float*)d_in[3]; p.kn0 = (const float*)d_in[4]; p.w_out[0] = (const float*)d_in[5];
    p.norm[1] = (const float*)d_in[6]; p.w_in[1] = (const float*)d_in[7]; p.w_out[1] = (const float*)d_in[8];
    p.norm[2] = (const float*)d_in[9]; p.w_in[2] = (const float*)d_in[10]; p.qn2 = (const float*)d_in[11]; p.kcn2 = (const float*)d_in[12];
    p.ksn2 = (const float*)d_in[13]; p.kwn2 = (const float*)d_in[14]; p.cwk = (const float*)d_in[15]; p.cwv = (const float*)d_in[16];
    p.cpos = (const float*)d_in[17]; p.w_out[2] = (const float*)d_in[18];
    p.norm[3] = (const float*)d_in[19]; p.w_in[3] = (const float*)d_in[20]; p.qn3 = (const float*)d_in[21]; p.kn3 = (const float*)d_in[22]; p.w_out[3] = (const float*)d_in[23];
    p.out = (float*)d_out; p.ws = (unsigned char*)d_ws;
    if (hipMemsetAsync((unsigned char*)d_ws + WS_BAR, 0, XCD_BAR_WORDS * sizeof(unsigned), stream) != hipSuccess) { fprintf(stderr, "kernel_launch: barrier memset failed\n"); return; }
    void* args[] = {&p};
    hipError_t e = hipLaunchCooperativeKernel((const void*)mega, dim3(grid_blocks), dim3(256), args, LDS_BYTES, stream);
    if (e != hipSuccess) fprintf(stderr, "cooperative launch failed: %s (grid %d)\n", hipGetErrorString(e), grid_blocks);
}
#ifdef TEST_ATT
__global__ void __launch_bounds__(256, 2) test_att(unsigned char* ws) {
    extern __shared__ __attribute__((aligned(16))) unsigned char smem[];
    for (int idx = blockIdx.x; idx < 1024; idx += gridDim.x) {
#if TEST_ATT == 0
        moba_item(ws, smem, idx, threadIdx.x);
#elif TEST_ATT == 1
        sb_item(ws, smem, idx, threadIdx.x);
#else
        nsa_item(ws, smem, idx, threadIdx.x);
#endif
    }
}
#endif
```

```cpp
#include <hip/hip_runtime.h>
#include <hip/hip_cooperative_groups.h>
#include <cstdio>
#include <cstdint>
namespace cg = cooperative_groups;

typedef unsigned short bf16_t;
using bf16x8 = __attribute__((ext_vector_type(8))) short;
using f32x16 = __attribute__((ext_vector_type(16))) float;
using u32x4v = __attribute__((ext_vector_type(4))) unsigned;
typedef float f32x2_t __attribute__((ext_vector_type(2)));
typedef __bf16 bf16x2_t __attribute__((ext_vector_type(2)));
#define DI __device__ __forceinline__
#define MFMA(a, b, c) __builtin_amdgcn_mfma_f32_32x32x16_bf16((a), (b), (c), 0, 0, 0)

constexpr int SEQ = 4096, DM = 2048, NTOK = 8192;
constexpr float EPS = 1e-6f, SCALE = 0.08838834764831845f, NEGF = -1e30f;
constexpr size_t MB = 1ull << 20;
constexpr size_t WS_WIN = 0, WS_WOUT = 32 * MB, WS_X = 64 * MB, WS_A = 128 * MB, WS_Q = 160 * MB, WS_K = 192 * MB, WS_VT = 224 * MB,
                 WS_G = 256 * MB, WS_OACC = 288 * MB, WS_ROPE = 352 * MB, WS_SSQ = 354 * MB, WS_KMP = 355 * MB, WS_CMPW = 356 * MB,
                 WS_CBIAS = 358 * MB, WS_BAR = 359 * MB, WS_END = 360 * MB;
constexpr int LDS_BYTES = 78848;
constexpr int LDS_XB = 78832;
constexpr int LDS_RED = 73728, LDS_RSD = 73728 + 2048, LDS_IMP = 69632, LDS_SELM = 69632 + 8192;

struct P {
    const float* x;
    const float* norm[4]; const float* w_in[4]; const float* w_out[4];
    const float* qn0; const float* kn0; const float* qn3; const float* kn3;
    const float* qn2; const float* kcn2; const float* ksn2; const float* kwn2;
    const float* cwk; const float* cwv; const float* cpos;
    float* out; unsigned char* ws;
};

DI unsigned cvtpk(float lo, float hi) { f32x2_t v = {lo, hi}; bf16x2_t b = __builtin_convertvector(v, bf16x2_t); return __builtin_bit_cast(unsigned, b); }
DI float bflo(unsigned u) { return __uint_as_float(u << 16); }
DI float bfhi(unsigned u) { return __uint_as_float(u & 0xffff0000u); }
DI int crow(int i, int h) { return (i & 3) + 8 * (i >> 2) + 4 * h; }
DI float sigmoidf_(float x) { return __builtin_amdgcn_rcpf(1.f + __expf(-x)); }

DI void conv_tile(const float* __restrict__ src, int K, int N, bf16_t* __restrict__ dst, int tile, float* ldsf, int tid) {
    asm volatile("" : "+v"(tid));
    const int ktiles = K >> 6;
    const int nt = tile / ktiles, kt = tile - nt * ktiles;
    const int n0 = nt * 64, k0 = kt * 64;
#pragma unroll
    for (int i = 0; i < 4; ++i) {
        const int c = tid + 256 * i;
        const int kr = c >> 4, nc = (c & 15) * 4;
        const int n = n0 + nc;
        float4 v = make_float4(0.f, 0.f, 0.f, 0.f);
        if (n < N) v = *(const float4*)(src + (size_t)(k0 + kr) * N + n);
        float* d = ldsf + kr * 65 + nc;
        d[0] = v.x; d[1] = v.y; d[2] = v.z; d[3] = v.w;
    }
    __syncthreads();
#pragma unroll
    for (int i = 0; i < 2; ++i) {
        const int c = tid + 256 * i;
        const int n = c >> 3, kc = (c & 7) * 8;
        const float* s = ldsf + kc * 65 + n;
        uint4 w;
        w.x = cvtpk(s[0], s[65]); w.y = cvtpk(s[130], s[195]); w.z = cvtpk(s[260], s[325]); w.w = cvtpk(s[390], s[455]);
        *(uint4*)(dst + (size_t)(n0 + n) * K + k0 + kc) = w;
    }
    __syncthreads();
}
DI void phase_convert(const float* src, int K, int N, int Npad, bf16_t* dst, float* ldsf, int tid, int bid, int nb) {
    const int ntiles = (Npad >> 6) * (K >> 6);
    for (int t = bid; t < ntiles; t += nb) conv_tile(src, K, N, dst, t, ldsf, tid);
}

struct Epi {
    int mode;
    bf16_t* dst; int ld; int s0;
    const float* gain; const float* ssq; const float* cbias;
    int pos_mul, pos_add;
    float* kmp; int vtS;
    const float* xold; float* xnew; bf16_t* anext; const float* gnext; float* ssq_out;
    const float* rope;
    float* p32;
};

DI void epilogue(const Epi& e, const float* C, float* red, const float* rsd, int tid) {
    const int l16 = tid & 15, rg = tid >> 4;
    if (e.mode == 2) {
        const int r8 = tid & 15, cgp = tid >> 4;
        float rs[8];
#pragma unroll
        for (int j = 0; j < 8; ++j) rs[j] = e.ssq ? rsd[r8 * 8 + j] : 1.f;
#pragma unroll 2
        for (int pass = 0; pass < 8; ++pass) {
            const int col = pass * 16 + cgp;
            const float bias = e.cbias ? e.cbias[col] : 0.f;
            float v[8];
#pragma unroll
            for (int j = 0; j < 8; ++j) v[j] = C[(r8 * 8 + j) * 132 + col] * rs[j] + bias;
            uint4 w; w.x = cvtpk(v[0], v[1]); w.y = cvtpk(v[2], v[3]); w.z = cvtpk(v[4], v[5]); w.w = cvtpk(v[6], v[7]);
            { const int sv = e.s0 + r8 * 8; *(uint4*)(e.dst + ((size_t)(sv >> 6) * 128 + col) * 64 + (sv & 63)) = w; }
        }
        return;
    }
    if (e.mode == 4) {
#pragma unroll 4
        for (int it = 0; it < 8; ++it) {
            const int row = it * 16 + rg;
            *(float4*)(e.p32 + (size_t)row * 128 + 4 * l16) = *(const float4*)(C + row * 132 + 4 * l16);
            *(float4*)(e.p32 + (size_t)row * 128 + 64 + 4 * l16) = *(const float4*)(C + row * 132 + 64 + 4 * l16);
        }
        return;
    }
    if (e.mode == 3) {
#pragma unroll 4
        for (int it = 0; it < 8; ++it) {
            const int row = it * 16 + rg;
            const float4 c0 = *(const float4*)(C + row * 132 + 4 * l16), c1 = *(const float4*)(C + row * 132 + 64 + 4 * l16);
            const float4 x0 = *(const float4*)(e.xold + (size_t)row * DM + 4 * l16), x1 = *(const float4*)(e.xold + (size_t)row * DM + 64 + 4 * l16);
            float4 n0, n1;
            n0.x = x0.x + c0.x; n0.y = x0.y + c0.y; n0.z = x0.z + c0.z; n0.w = x0.w + c0.w;
            n1.x = x1.x + c1.x; n1.y = x1.y + c1.y; n1.z = x1.z + c1.z; n1.w = x1.w + c1.w;
            *(float4*)(e.xnew + (size_t)row * DM + 4 * l16) = n0;
            *(float4*)(e.xnew + (size_t)row * DM + 64 + 4 * l16) = n1;
            if (e.anext) {
                float ss = n0.x * n0.x + n0.y * n0.y + n0.z * n0.z + n0.w * n0.w + n1.x * n1.x + n1.y * n1.y + n1.z * n1.z + n1.w * n1.w;
                ss += __shfl_xor(ss, 8); ss += __shfl_xor(ss, 4); ss += __shfl_xor(ss, 2); ss += __shfl_xor(ss, 1);
                if (l16 == 0) e.ssq_out[row] = ss;
                const float4 g0 = *(const float4*)(e.gnext + 4 * l16), g1 = *(const float4*)(e.gnext + 64 + 4 * l16);
                uint2 w0, w1;
                w0.x = cvtpk(n0.x * g0.x, n0.y * g0.y); w0.y = cvtpk(n0.z * g0.z, n0.w * g0.w);
                w1.x = cvtpk(n1.x * g1.x, n1.y * g1.y); w1.y = cvtpk(n1.z * g1.z, n1.w * g1.w);
                *(uint2*)(e.anext + (size_t)row * DM + 4 * l16) = w0;
                *(uint2*)(e.anext + (size_t)row * DM + 64 + 4 * l16) = w1;
            }
        }
        return;
    }
    float cs[8];
#pragma unroll
    for (int j = 0; j < 8; ++j) cs[j] = 0.f;
    float bia[8];
#pragma unroll
    for (int j = 0; j < 4; ++j) { bia[j] = e.cbias ? e.cbias[4 * l16 + j] : 0.f; bia[4 + j] = e.cbias ? e.cbias[64 + 4 * l16 + j] : 0.f; }
#pragma unroll 4
    for (int it = 0; it < 8; ++it) {
        const int row = it * 16 + rg;
        const float rs = e.ssq ? rsd[row] : 1.f;
        const float4 c0 = *(const float4*)(C + row * 132 + 4 * l16), c1 = *(const float4*)(C + row * 132 + 64 + 4 * l16);
        float v[8] = {c0.x * rs + bia[0], c0.y * rs + bia[1], c0.z * rs + bia[2], c0.w * rs + bia[3],
                      c1.x * rs + bia[4], c1.y * rs + bia[5], c1.z * rs + bia[6], c1.w * rs + bia[7]};
        if (e.mode == 1) {
            float ss = 0.f;
#pragma unroll
            for (int j = 0; j < 8; ++j) ss += v[j] * v[j];
            ss += __shfl_xor(ss, 8); ss += __shfl_xor(ss, 4); ss += __shfl_xor(ss, 2); ss += __shfl_xor(ss, 1);
            const float inv = rsqrtf(ss * (1.f / 128.f) + EPS);
            const float4 g0 = *(const float4*)(e.gain + 4 * l16), g1 = *(const float4*)(e.gain + 64 + 4 * l16);
            v[0] *= inv * g0.x; v[1] *= inv * g0.y; v[2] *= inv * g0.z; v[3] *= inv * g0.w;
            v[4] *= inv * g1.x; v[5] *= inv * g1.y; v[6] *= inv * g1.z; v[7] *= inv * g1.w;
            int pos = (e.s0 + row) * e.pos_mul + e.pos_add;
            pos = pos > 4095 ? 4095 : pos;
            const float4 cc = *(const float4*)(e.rope + pos * 64 + 4 * l16), sn = *(const float4*)(e.rope + 262144 + pos * 64 + 4 * l16);
            const float a0 = v[0] * cc.x - v[4] * sn.x, b0 = v[4] * cc.x + v[0] * sn.x;
            const float a1 = v[1] * cc.y - v[5] * sn.y, b1 = v[5] * cc.y + v[1] * sn.y;
            const float a2 = v[2] * cc.z - v[6] * sn.z, b2 = v[6] * cc.z + v[2] * sn.z;
            const float a3 = v[3] * cc.w - v[7] * sn.w, b3 = v[7] * cc.w + v[3] * sn.w;
            v[0] = a0; v[1] = a1; v[2] = a2; v[3] = a3; v[4] = b0; v[5] = b1; v[6] = b2; v[7] = b3;
#pragma unroll
            for (int j = 0; j < 8; ++j) cs[j] += v[j];
        }
        uint2 w0, w1;
        w0.x = cvtpk(v[0], v[1]); w0.y = cvtpk(v[2], v[3]); w1.x = cvtpk(v[4], v[5]); w1.y = cvtpk(v[6], v[7]);
        bf16_t* d = e.dst + (size_t)(e.s0 + row) * e.ld;
        *(uint2*)(d + 4 * l16) = w0;
        *(uint2*)(d + 64 + 4 * l16) = w1;
    }
    if (e.kmp) {
        const int lane = tid & 63, wave = tid >> 6;
#pragma unroll
        for (int j = 0; j < 8; ++j) { cs[j] += __shfl_xor(cs[j], 16); cs[j] += __shfl_xor(cs[j], 32); }
        if (lane < 16) {
#pragma unroll
            for (int j = 0; j < 4; ++j) { red[wave * 128 + 4 * lane + j] = cs[j]; red[wave * 128 + 64 + 4 * lane + j] = cs[4 + j]; }
        }
        __syncthreads();
        if (tid < 128) e.kmp[tid] = red[tid] + red[128 + tid] + red[256 + tid] + red[384 + tid];
    }
}

DI void gemm_tile(const bf16_t* __restrict__ A, int lda, const bf16_t* __restrict__ Bt, int ldb, int K,
                  unsigned char* smem, const Epi& e0, int tid) {
    asm volatile("" : "+v"(tid));
    bf16_t* As = (bf16_t*)smem;
    bf16_t* Bs = As + 256 * 72;
    const int lane = tid & 63, wave = tid >> 6, r = lane & 31, h = lane >> 5;
    const int wm = (wave >> 1) * 128, wn = (wave & 1) * 64;
    const int lrow = tid >> 3, lkc = (tid & 7) * 8;
    const bf16_t* ag = A + (size_t)lrow * lda + lkc;
    const bf16_t* bg = Bt + (size_t)lrow * ldb + lkc;
    u32x4v ra[8], rb[4];
    f32x16 acc[4][2];
#pragma unroll
    for (int i = 0; i < 4; ++i)
#pragma unroll
        for (int j = 0; j < 2; ++j)
#pragma unroll
            for (int q = 0; q < 16; ++q) acc[i][j][q] = 0.f;
#define GLA(i_, k0) { ra[i_] = *(const u32x4v*)(ag + (size_t)(32 * i_) * lda + (k0)); }
#define GLB(i_, k0) { rb[i_] = *(const u32x4v*)(bg + (size_t)(32 * i_) * ldb + (k0)); }
#define GL(k0) { GLA(0, k0) GLA(1, k0) GLA(2, k0) GLA(3, k0) GLA(4, k0) GLA(5, k0) GLA(6, k0) GLA(7, k0) GLB(0, k0) GLB(1, k0) GLB(2, k0) GLB(3, k0) }
#define LSA(i_) { *(u32x4v*)(As + (lrow + 32 * i_) * 72 + lkc) = ra[i_]; }
#define LSB(i_) { *(u32x4v*)(Bs + (lrow + 32 * i_) * 72 + lkc) = rb[i_]; }
#define LS() { LSA(0) LSA(1) LSA(2) LSA(3) LSA(4) LSA(5) LSA(6) LSA(7) LSB(0) LSB(1) LSB(2) LSB(3) }
#define LDA01(ks) { fa[0] = *(const bf16x8*)(As + (wm + r) * 72 + h * 8 + (ks) * 16); fa[1] = *(const bf16x8*)(As + (wm + 32 + r) * 72 + h * 8 + (ks) * 16); }
#define LDA23(ks) { fa[2] = *(const bf16x8*)(As + (wm + 64 + r) * 72 + h * 8 + (ks) * 16); fa[3] = *(const bf16x8*)(As + (wm + 96 + r) * 72 + h * 8 + (ks) * 16); }
#define LDB(ks, s_) { fb[s_][0] = *(const bf16x8*)(Bs + (wn + r) * 72 + h * 8 + (ks) * 16); fb[s_][1] = *(const bf16x8*)(Bs + (wn + 32 + r) * 72 + h * 8 + (ks) * 16); }
#define MM01(s_) { acc[0][0] = MFMA(fa[0], fb[s_][0], acc[0][0]); acc[0][1] = MFMA(fa[0], fb[s_][1], acc[0][1]); acc[1][0] = MFMA(fa[1], fb[s_][0], acc[1][0]); acc[1][1] = MFMA(fa[1], fb[s_][1], acc[1][1]); }
#define MM23(s_) { acc[2][0] = MFMA(fa[2], fb[s_][0], acc[2][0]); acc[2][1] = MFMA(fa[2], fb[s_][1], acc[2][1]); acc[3][0] = MFMA(fa[3], fb[s_][0], acc[3][0]); acc[3][1] = MFMA(fa[3], fb[s_][1], acc[3][1]); }
#define SBAR __builtin_amdgcn_sched_barrier(0);
#define KSTEP(ks, s_, last) { LDA23(ks) SBAR MM01(s_) SBAR if (!(last)) { LDA01((ks) + 1) LDB((ks) + 1, (s_) ^ 1) } SBAR MM23(s_) SBAR }
#define KSTEP0(ks, s_) { MM01(s_) SBAR LDA01((ks) + 1) LDB((ks) + 1, (s_) ^ 1) SBAR MM23(s_) SBAR }
    bf16x8 fa[4], fb[2][2];
    const int nk = K >> 6;
    if (e0.ssq) {
        float ssum = 0.f;
#pragma unroll
        for (int pp = 0; pp < 16; ++pp) ssum += e0.ssq[pp * NTOK + tid];
        ((float*)(smem + LDS_RSD))[tid] = rsqrtf(ssum * (1.f / 2048.f) + EPS);
    }
    GL(0);
    for (int kt = 0; kt < nk; ++kt) {
        LS();
        __syncthreads();
        LDA01(0) LDB(0, 0) LDA23(0) SBAR
        if (kt + 1 < nk) { GL((kt + 1) * 64); }
        SBAR KSTEP0(0, 0) KSTEP(1, 1, false) KSTEP(2, 0, false) KSTEP(3, 1, true)
        __syncthreads();
    }
#undef GL
#undef LS
#undef GLA
#undef GLB
#undef LSA
#undef LSB
#undef LDA01
#undef LDA23
#undef LDB
#undef MM01
#undef MM23
#undef SBAR
#undef KSTEP
#undef KSTEP0
    float* C = (float*)smem;
    float* red = (float*)(smem + LDS_RED);
    float* rsd = (float*)(smem + LDS_RSD);
#pragma unroll
    for (int half = 0; half < 2; ++half) {
        Epi e = e0;
        if (half) {
            e.s0 += 128;
            if (e.ssq) e.ssq += 128;
            if (e.kmp) e.kmp += 128;
            if (e.xold) { e.xold += (size_t)128 * DM; e.xnew += (size_t)128 * DM; }
            if (e.anext) { e.anext += (size_t)128 * DM; e.ssq_out += 128; }
            if (e.p32) e.p32 += 128 * 128;
        }
        if ((wave >> 1) == half) {
#pragma unroll
            for (int i = 0; i < 4; ++i)
#pragma unroll
                for (int j = 0; j < 2; ++j)
#pragma unroll
                    for (int q = 0; q < 16; ++q) C[(32 * i + crow(q, h)) * 132 + wn + 32 * j + r] = acc[i][j][q];
        }
        __syncthreads();
        epilogue(e, C, red, rsd + half * 128, tid);
        __syncthreads();
    }
}

DI void reduce_tile(const float* __restrict__ P, int nparts, size_t pstride, unsigned char* smem, const Epi& e0, int tid) {
    asm volatile("" : "+v"(tid));
    float* C = (float*)smem;
    float* red = (float*)(smem + LDS_RED);
    float* rsd = (float*)(smem + LDS_RSD);
    for (int half = 0; half < 2; ++half) {
        Epi e = e0;
        if (half) e.s0 += 128;
        for (int c = tid; c < 128 * 32; c += 256) {
            const int row = c >> 5, c4 = (c & 31) * 4;
            float4 a = make_float4(0.f, 0.f, 0.f, 0.f);
            for (int pp = 0; pp < nparts; ++pp) {
                const float4 v = *(const float4*)(P + (size_t)pp * pstride + (size_t)(half * 128 + row) * 128 + c4);
                a.x += v.x; a.y += v.y; a.z += v.z; a.w += v.w;
            }
            *(float4*)(C + row * 132 + c4) = a;
        }
        __syncthreads();
        epilogue(e, C, red, rsd, tid);
        __syncthreads();
    }
}

enum { K_MOBA = 0, K_SB = 1, K_CMP = 2, K_SLC = 3, K_WIN = 4 };
enum { M_SOFT = 0, M_SB = 1, M_CMP1 = 2, M_CMP2 = 3 };

template <int KIND> DI int seq_next(int t, unsigned long long U) {
    if (KIND == K_SB) return t - 1;
    if (KIND == K_SLC) { ++t; while (t < 64 && !((U >> t) & 1ull)) ++t; return t; }
    return t + 1;
}

DI void qk_block(const bf16x8 (&qf)[8], const bf16_t* Ks, int kb, int r, int h, f32x16& s) {
#pragma unroll
    for (int q = 0; q < 16; ++q) s[q] = 0.f;
    const bf16_t* kp = Ks + (kb * 32 + r) * 136 + h * 8;
#pragma unroll
    for (int st = 0; st < 8; ++st) {
        const bf16x8 a = *(const bf16x8*)(kp + st * 16);
        s = MFMA(a, qf[st], s);
        if (st == 3) __builtin_amdgcn_sched_barrier(0);
    }
}
DI void pv_block(f32x16 (&o)[4], const f32x16& p, const bf16_t* Vs, int kb, int r, int h) {
#pragma unroll
    for (int s2 = 0; s2 < 2; ++s2) {
        u32x4v pw;
        pw[0] = cvtpk(p[8 * s2 + 0], p[8 * s2 + 1]); pw[1] = cvtpk(p[8 * s2 + 2], p[8 * s2 + 3]);
        pw[2] = cvtpk(p[8 * s2 + 4], p[8 * s2 + 5]); pw[3] = cvtpk(p[8 * s2 + 6], p[8 * s2 + 7]);
        const bf16x8 pb = __builtin_bit_cast(bf16x8, pw);
#pragma unroll
        for (int db = 0; db < 4; ++db) {
            const bf16_t* vp = Vs + (db * 32 + r) * 68 + kb * 32 + s2 * 16 + 4 * h;
            const uint2 lo = *(const uint2*)vp, hi = *(const uint2*)(vp + 8);
            u32x4v aw; aw[0] = lo.x; aw[1] = lo.y; aw[2] = hi.x; aw[3] = hi.y;
            o[db] = MFMA(__builtin_bit_cast(bf16x8, aw), pb, o[db]);
        }
    }
}

DI void sb_block(f32x16& s, int keyb, int h, int khi, float& carry) {
    float lk[16];
#pragma unroll
    for (int i = 0; i < 16; ++i) {
        const float z = s[i] * SCALE;
        const bool valid = (keyb + crow(i, h)) <= khi;
        const float ls = fminf(z, 0.f) - __logf(1.f + __expf(-fabsf(z)));
        lk[i] = valid ? (ls - z) : 0.f;
        s[i] = valid ? ls : -3e38f;
    }
    float g[4], pg[4], aft[4];
#pragma unroll
    for (int a = 0; a < 4; ++a) { g[a] = (lk[4 * a] + lk[4 * a + 1]) + (lk[4 * a + 2] + lk[4 * a + 3]); pg[a] = __shfl_xor(g[a], 32); }
    float run = 0.f;
#pragma unroll
    for (int a = 3; a >= 0; --a) { aft[a] = run + (h == 0 ? pg[a] : 0.f); run += g[a] + pg[a]; }
#pragma unroll
    for (int a = 0; a < 4; ++a) {
        float within = 0.f;
#pragma unroll
        for (int b = 3; b >= 0; --b) {
            const float la = carry + aft[a] + within;
            const float ls = s[4 * a + b];
            s[4 * a + b] = (ls > -1e38f) ? __expf(ls + la) : 0.f;
            within += lk[4 * a + b];
        }
    }
    carry += run;
}

template <int KIND, int MODE>
DI void flash(unsigned char* smem, const bf16_t* __restrict__ Kp, int ldk, const bf16_t* __restrict__ Vp, int ldv, int first, int nt,
              unsigned long long U, const bf16x8 (&qf)[8], f32x16 (&o)[4], float& m, float& l, int t, int cur, unsigned long long sel,
              float inv_l, float* imp, int tid) {
    const int lane = tid & 63, wave = tid >> 6, r = lane & 31, h = lane >> 5;
    u32x4v rk[4], rv[4];
#define GLT1(i_, key0_) { const int c_ = tid + 256 * i_; \
        rk[i_] = *(const u32x4v*)(Kp + (size_t)((key0_) + (c_ >> 4)) * ldk + (c_ & 15) * 8); \
        rv[i_] = *(const u32x4v*)(Vp + (size_t)(key0_) * 128 + (c_ >> 3) * 64 + (c_ & 7) * 8); }
#define GLT(tile) { const int k0__ = (tile) * 64; GLT1(0, k0__) GLT1(1, k0__) GLT1(2, k0__) GLT1(3, k0__) }
#define LST1(i_, ks_, vs_) { const int c_ = tid + 256 * i_; \
        *(u32x4v*)(ks_ + (c_ >> 4) * 136 + (c_ & 15) * 8) = rk[i_]; \
        uint2* vd_ = (uint2*)(vs_ + (c_ >> 3) * 68 + (c_ & 7) * 8); vd_[0] = make_uint2(rv[i_][0], rv[i_][1]); vd_[1] = make_uint2(rv[i_][2], rv[i_][3]); }
#define LST(buf) { bf16_t* ks__ = (bf16_t*)(smem + (buf) * 34816); bf16_t* vs__ = ks__ + 64 * 136; LST1(0, ks__, vs__) LST1(1, ks__, vs__) LST1(2, ks__, vs__) LST1(3, ks__, vs__) }
    int tf = first;
    GLT(tf);
    LST(0);
    if (nt > 1) { tf = seq_next<KIND>(tf, U); GLT(tf); }
    __syncthreads();
    int tc = first;
    for (int it = 0; it < nt; ++it) {
        const int buf = it & 1;
        if (it + 1 < nt) { LST(buf ^ 1); }
        if (it + 2 < nt) { tf = seq_next<KIND>(tf, U); GLT(tf); }
        const bf16_t* Ks = (const bf16_t*)(smem + buf * 34816);
        const bf16_t* Vs = Ks + 64 * 136;
        bool lsel = true; int klo = 0, khi = 0;
        if (KIND == K_MOBA) { const int blk = tc >> 2; if (blk < cur) { lsel = (sel >> blk) & 1ull; khi = 1 << 30; } else { khi = t; } }
        else if (KIND == K_SB) { khi = t - 1; }
        else if (KIND == K_CMP) { khi = (t - 31) >> 4; }
        else if (KIND == K_SLC) { lsel = (sel >> tc) & 1ull; khi = t; }
        else { klo = t - 511; khi = t; }
        const int key0 = tc * 64;
        const bool act = lsel && (key0 <= khi) && (key0 + 63 >= klo) && (KIND != K_SB || l > -110.f);
        const bool wact = (KIND == K_CMP) ? true : (__ballot(act) != 0ull);
        if (wact) {
#pragma unroll
            for (int kk = 0; kk < 2; ++kk) {
                const int kb = (MODE == M_SB) ? 1 - kk : kk;
                const int keyb = key0 + 32 * kb;
                const bool bact = (KIND == K_CMP) ? true : (__ballot(act && (keyb <= khi) && (keyb + 31 >= klo)) != 0ull);
                if (bact) {
                    f32x16 s;
                    qk_block(qf, Ks, kb, r, h, s);
                    if (MODE == M_SB) {
                        sb_block(s, keyb, h, khi, l);
                        pv_block(o, s, Vs, kb, r, h);
                    } else if (MODE == M_CMP2) {
#pragma unroll
                        for (int i = 0; i < 16; ++i) s[i] = (keyb + crow(i, h) <= khi) ? __expf(s[i] * SCALE - m) * inv_l : 0.f;
                        pv_block(o, s, Vs, kb, r, h);
                        float gs_[4], p3_[4];
#pragma unroll
                        for (int a = 0; a < 4; ++a) { gs_[a] = (s[4 * a] + s[4 * a + 1]) + (s[4 * a + 2] + s[4 * a + 3]); p3_[a] = s[4 * a + 3]; }
                        for (int w = 0; w < 4; ++w) {
                            if (wave == w) {
#pragma unroll
                                for (int a = 0; a < 4; ++a) {
                                    const int j = 16 * tc + 8 * kb + 2 * a + h;
                                    imp[j * 32 + r] += gs_[a];
                                    if (j + 1 < 64) imp[(j + 1) * 32 + r] += p3_[a];
                                }
                            }
                            __syncthreads();
                        }
                    } else {
                        const bool lall = lsel && (keyb >= klo) && (keyb + 31 <= khi);
                        const bool lnone = !(lsel && (keyb <= khi) && (keyb + 31 >= klo));
                        float mnew, alpha, rs = 0.f;
                        if (__ballot(!(lall || lnone)) == 0ull) {
                            constexpr float CL2 = SCALE * 1.4426950408889634f;
                            float mx = s[0];
#pragma unroll
                            for (int i = 1; i < 16; ++i) mx = fmaxf(mx, s[i]);
                            mx = lall ? mx * SCALE : NEGF;
                            mx = fmaxf(mx, __shfl_xor(mx, 32));
                            const bool grow = mx > m + 8.f;
                            mnew = grow ? mx : m;
                            alpha = grow ? __expf(m - mnew) : 1.f;
                            const float mexp = lall ? mnew * 1.4426950408889634f : 3e38f;
#pragma unroll
                            for (int i = 0; i < 16; ++i) s[i] = __builtin_amdgcn_exp2f(__builtin_fmaf(s[i], CL2, -mexp));
#pragma unroll
                            for (int i = 0; i < 16; ++i) rs += s[i];
                        } else {
                            float mx = NEGF;
#pragma unroll
                            for (int i = 0; i < 16; ++i) {
                                const int k_ = keyb + crow(i, h);
                                const bool v_ = lsel && (k_ >= klo) && (k_ <= khi);
                                s[i] = v_ ? s[i] * SCALE : NEGF;
                                mx = fmaxf(mx, s[i]);
                            }
                            mx = fmaxf(mx, __shfl_xor(mx, 32));
                            mnew = fmaxf(m, mx);
                            alpha = __expf(m - mnew);
#pragma unroll
                            for (int i = 0; i < 16; ++i) {
                                const float p_ = (s[i] > -5e29f) ? __expf(s[i] - mnew) : 0.f;
                                s[i] = p_; rs += p_;
                            }
                        }
                        rs += __shfl_xor(rs, 32);
                        l = l * alpha + rs;
                        if (MODE == M_SOFT) {
                            if (__ballot(mnew > m) != 0ull) {
#pragma unroll
                                for (int db = 0; db < 4; ++db)
#pragma unroll
                                    for (int q = 0; q < 16; ++q) o[db][q] *= alpha;
                            }
                            pv_block(o, s, Vs, kb, r, h);
                        }
                        m = mnew;
                    }
                }
                __builtin_amdgcn_sched_barrier(0);
            }
        }
        if (KIND == K_SB) {
            volatile int* flags = (volatile int*)(smem + LDS_SELM);
            const bool wdone = __ballot((l > -110.f) && (khi >= 0)) == 0ull;
            if (wdone && lane == 0) flags[wave] = 1;
            __syncthreads();
            if (flags[0] & flags[1] & flags[2] & flags[3]) break;
        } else {
            __syncthreads();
        }
        tc = seq_next<KIND>(tc, U);
    }
#undef GLT
#undef LST
#undef GLT1
#undef LST1
}

DI void load_q(bf16x8 (&qf)[8], const bf16_t* qrow, int h) {
#pragma unroll
    for (int st = 0; st < 8; ++st) qf[st] = *(const bf16x8*)(qrow + st * 16 + h * 8);
}
DI void zero_o(f32x16 (&o)[4]) {
#pragma unroll
    for (int db = 0; db < 4; ++db)
#pragma unroll
        for (int q = 0; q < 16; ++q) o[db][q] = 0.f;
}
DI void write_y(const f32x16 (&o)[4], float sc, const bf16_t* acc1, const bf16_t* acc2, const bf16_t* grow, bf16_t* yrow, int h) {
#pragma unroll
    for (int db = 0; db < 4; ++db)
#pragma unroll
        for (int a = 0; a < 4; ++a) {
            const int d = 32 * db + 8 * a + 4 * h;
            float v0 = o[db][4 * a] * sc, v1 = o[db][4 * a + 1] * sc, v2 = o[db][4 * a + 2] * sc, v3 = o[db][4 * a + 3] * sc;
            if (acc1) { const uint2 b1 = *(const uint2*)(acc1 + d), b2 = *(const uint2*)(acc2 + d);
                v0 += bflo(b1.x) + bflo(b2.x); v1 += bfhi(b1.x) + bfhi(b2.x); v2 += bflo(b1.y) + bflo(b2.y); v3 += bfhi(b1.y) + bfhi(b2.y); }
            const uint2 gg = *(const uint2*)(grow + d);
            const float g0 = bflo(gg.x), g1 = bfhi(gg.x), g2 = bflo(gg.y), g3 = bfhi(gg.y);
            uint2 w;
            w.x = cvtpk(v0 * g0 * sigmoidf_(g0), v1 * g1 * sigmoidf_(g1));
            w.y = cvtpk(v2 * g2 * sigmoidf_(g2), v3 * g3 * sigmoidf_(g3));
            *(uint2*)(yrow + d) = w;
            if (a == 3) __builtin_amdgcn_sched_barrier(0);
        }
}
DI void acc_store(const f32x16 (&o)[4], float sc, bf16_t* accrow, int h) {
#pragma unroll
    for (int db = 0; db < 4; ++db)
#pragma unroll
        for (int a = 0; a < 4; ++a) {
            const int d = 32 * db + 8 * a + 4 * h;
            uint2 w;
            w.x = cvtpk(o[db][4 * a] * sc, o[db][4 * a + 1] * sc);
            w.y = cvtpk(o[db][4 * a + 2] * sc, o[db][4 * a + 3] * sc);
            *(uint2*)(accrow + d) = w;
        }
}

DI const float* sel4(int i, const float* a, const float* b, const float* c, const float* d) { return i == 0 ? a : (i == 1 ? b : (i == 2 ? c : d)); }
DI bool panel_tile(int i, int bid, int nb, int NT, int PW, int& mt, int& nt) {
    if (nb & 7) { const int tI = bid + i * nb; if (tI >= 32 * NT) return false; mt = tI / NT; nt = tI - mt * NT; return true; }
    const int x = bid & 7, nl = nb >> 3, NP = (NT + PW - 1) / PW;
    int u = (bid >> 3) + i * nl;
    for (int p = x; p < NP; p += 8) {
        const int w = (NT - p * PW) < PW ? (NT - p * PW) : PW;
        const int cnt = 32 * w;
        if (u < cnt) { mt = u / w; nt = p * PW + (u - mt * w); return true; }
        u -= cnt;
    }
    return false;
}
DI int snake(int rd, int bid, int nb) { return rd * nb + ((rd & 1) ? (nb - 1 - bid) : bid); }

DI void moba_item(unsigned char* ws, unsigned char* smem, int idx, int tid) {
    asm volatile("" : "+v"(tid));
    const int lane = tid & 63, wave = tid >> 6, r = lane & 31, h = lane >> 5;
    const int qt = 31 - (idx >> 5), bh = idx & 31, b = bh >> 4, head = bh & 15;
    const int q0 = qt * 128, cur = q0 >> 8;
    const int t = q0 + 32 * wave + r;
    bf16_t* Q = (bf16_t*)(ws + WS_Q);
    const bf16_t* Kb = (const bf16_t*)(ws + WS_K) + (size_t)bh * SEQ * 128;
    const bf16_t* Vt = (const bf16_t*)(ws + WS_VT) + (size_t)bh * 128 * SEQ;
    const bf16_t* G = (const bf16_t*)(ws + WS_G);
    const float* kmp = (const float*)(ws + WS_KMP) + (size_t)bh * 32 * 128;
    const size_t rowoff = (size_t)(b * SEQ + t) * DM + head * 128;
    bf16x8 qf[8];
    load_q(qf, Q + rowoff, h);
    unsigned long long sel = 0ull;
    if (cur > 0) {
        f32x16 gacc;
#pragma unroll
        for (int q = 0; q < 16; ++q) gacc[q] = 0.f;
        const bool vrow = r < cur;
        const float* k0p = kmp + (size_t)(2 * r) * 128 + h * 8;
#pragma unroll
        for (int st = 0; st < 8; ++st) {
            float km[8];
#pragma unroll
            for (int j = 0; j < 8; ++j) km[j] = 0.f;
            if (vrow) {
                const float4 a0 = *(const float4*)(k0p + st * 16), a1 = *(const float4*)(k0p + st * 16 + 4);
                const float4 c0 = *(const float4*)(k0p + 128 + st * 16), c1 = *(const float4*)(k0p + 128 + st * 16 + 4);
                km[0] = (a0.x + c0.x) * (1.f / 256.f); km[1] = (a0.y + c0.y) * (1.f / 256.f); km[2] = (a0.z + c0.z) * (1.f / 256.f); km[3] = (a0.w + c0.w) * (1.f / 256.f);
                km[4] = (a1.x + c1.x) * (1.f / 256.f); km[5] = (a1.y + c1.y) * (1.f / 256.f); km[6] = (a1.z + c1.z) * (1.f / 256.f); km[7] = (a1.w + c1.w) * (1.f / 256.f);
            }
            u32x4v hi, lo;
#pragma unroll
            for (int j = 0; j < 4; ++j) {
                const unsigned hw = cvtpk(km[2 * j], km[2 * j + 1]);
                hi[j] = hw;
                lo[j] = cvtpk(km[2 * j] - bflo(hw), km[2 * j + 1] - bfhi(hw));
            }
            gacc = MFMA(__builtin_bit_cast(bf16x8, hi), qf[st], gacc);
            gacc = MFMA(__builtin_bit_cast(bf16x8, lo), qf[st], gacc);
        }
        float gv[16];
#pragma unroll
        for (int a = 0; a < 2; ++a)
#pragma unroll
            for (int bb = 0; bb < 4; ++bb) {
                const float own = gacc[4 * a + bb];
                const float oth = __shfl_xor(own, 32);
                gv[8 * a + bb] = (h == 0) ? own : oth;
                gv[8 * a + 4 + bb] = (h == 0) ? oth : own;
            }
        unsigned smask = 0u;
#pragma unroll
        for (int k = 0; k < 3; ++k) {
            float bv = -3e38f; int bi = -1;
#pragma unroll
            for (int n = 0; n < 16; ++n) {
                const bool ok = (n < cur) && !((smask >> n) & 1u) && (gv[n] > bv);
                bv = ok ? gv[n] : bv; bi = ok ? n : bi;
            }
            if (bi >= 0) smask |= 1u << bi;
        }
        sel = smask;
    }
    f32x16 o[4];
    zero_o(o);
    float m = NEGF, l = 0.f;
    const int nt = (q0 + 128) >> 6;
    flash<K_MOBA, M_SOFT>(smem, Kb, 128, Vt, SEQ, 0, nt, 0ull, qf, o, m, l, t, cur, sel, 0.f, nullptr, tid);
    write_y(o, 1.f / l, nullptr, nullptr, G + rowoff, Q + rowoff, h);
}

DI void sb_item(unsigned char* ws, unsigned char* smem, int idx, int tid) {
    asm volatile("" : "+v"(tid));
    const int lane = tid & 63, wave = tid >> 6, r = lane & 31, h = lane >> 5;
    const int qt = 31 - (idx >> 5), bh = idx & 31, b = bh >> 4, head = bh & 15;
    const int q0 = qt * 128;
    const int t = q0 + 32 * wave + r;
    bf16_t* Q = (bf16_t*)(ws + WS_Q);
    const bf16_t* Kb = (const bf16_t*)(ws + WS_K) + (size_t)bh * SEQ * 128;
    const bf16_t* Vt = (const bf16_t*)(ws + WS_VT) + (size_t)bh * 128 * SEQ;
    const bf16_t* G = (const bf16_t*)(ws + WS_G);
    const size_t rowoff = (size_t)(b * SEQ + t) * DM + head * 128;
    bf16x8 qf[8];
    load_q(qf, Q + rowoff, h);
    f32x16 o[4];
    zero_o(o);
    float m = 0.f, carry = 0.f;
    const int nt = (q0 + 128) >> 6;
    __syncthreads();
    if (tid < 4) ((volatile int*)(smem + LDS_SELM))[tid] = 0;
    flash<K_SB, M_SB>(smem, Kb, 128, Vt, SEQ, nt - 1, nt, 0ull, qf, o, m, carry, t, 0, 0ull, 0.f, nullptr, tid);
    write_y(o, 1.f, nullptr, nullptr, G + rowoff, Q + rowoff, h);
}

DI void nsa_item(unsigned char* ws, unsigned char* smem, int idx, int tid) {
    asm volatile("" : "+v"(tid));
    const int lane = tid & 63, wave = tid >> 6, r = lane & 31, h = lane >> 5;
    const int c = 127 - (idx >> 3), bg = idx & 7, b = bg >> 2, g = bg & 3;
    const int head = g * 4 + wave;
    const int q0 = c * 32, t = q0 + r, cur = q0 >> 6;
    bf16_t* Q = (bf16_t*)(ws + WS_Q);
    const bf16_t* G = (const bf16_t*)(ws + WS_G);
    const bf16_t* KS = (const bf16_t*)(ws + WS_K + 16 * MB) + (size_t)bg * SEQ * 128;
    const bf16_t* KW = (const bf16_t*)(ws + WS_K + 24 * MB) + (size_t)bg * SEQ * 128;
    const bf16_t* VST = (const bf16_t*)(ws + WS_VT) + (size_t)bg * 128 * SEQ;
    const bf16_t* VWT = (const bf16_t*)(ws + WS_VT + 8 * MB) + (size_t)bg * 128 * SEQ;
    const bf16_t* KCC = (const bf16_t*)(ws + WS_VT + 16 * MB) + (size_t)bg * 256 * 128;
    const bf16_t* VCCT = (const bf16_t*)(ws + WS_VT + 17 * MB) + (size_t)bg * 128 * 256;
    const bf16_t* BG = (const bf16_t*)(ws + WS_VT + 18 * MB);
    float* imp = (float*)(smem + LDS_IMP);
    uint2* selm = (uint2*)(smem + LDS_SELM);
    const size_t tok = (size_t)(b * SEQ + t);
    const size_t rowoff = tok * DM + head * 128;
    bf16_t* acc1 = (bf16_t*)(ws + WS_OACC) + rowoff;
    bf16_t* acc2 = (bf16_t*)(ws + WS_OACC + 32 * MB) + rowoff;
    bf16x8 qf[8];
    load_q(qf, Q + rowoff, h);
    for (int i = tid; i < 2048; i += 256) imp[i] = 0.f;
    f32x16 o[4];
    zero_o(o);
    float m = NEGF, l = 0.f;
    const int ntc = (q0 >> 10) + 1;
#ifndef X_NOCMP1
    flash<K_CMP, M_CMP1>(smem, KCC, 128, VCCT, 256, 0, ntc, 0ull, qf, o, m, l, t, cur, 0ull, 0.f, nullptr, tid);
#endif
    const float invl = 1.f / fmaxf(l, 1e-30f);
#ifndef X_NOCMP2
    flash<K_CMP, M_CMP2>(smem, KCC, 128, VCCT, 256, 0, ntc, 0ull, qf, o, m, l, t, cur, 0ull, invl, imp, tid);
#endif
    { const float g0 = sigmoidf_(__uint_as_float((unsigned)BG[tok * 128 + head] << 16)); acc_store(o, g0, acc1, h); }
#ifndef X_NOTOPK
    {
        const int q = tid >> 3, sub = tid & 7;
        float myv[8]; int rank[8];
#pragma unroll
        for (int k = 0; k < 8; ++k) {
            const int j = sub * 8 + k;
            const float v = imp[j * 32 + q];
            myv[k] = (j > cur) ? NEGF : ((j == 0 || j == cur || j == cur - 1) ? 1e30f : v);
            rank[k] = 0;
        }
        for (int jj = 0; jj < 64; ++jj) {
            float v = imp[jj * 32 + q];
            v = (jj > cur) ? NEGF : ((jj == 0 || jj == cur || jj == cur - 1) ? 1e30f : v);
#pragma unroll
            for (int k = 0; k < 8; ++k) { const int j = sub * 8 + k; rank[k] += ((v > myv[k]) || (v == myv[k] && jj < j)) ? 1 : 0; }
        }
        unsigned bits = 0u;
#pragma unroll
        for (int k = 0; k < 8; ++k) if (rank[k] < 16 && (sub * 8 + k) <= cur) bits |= 1u << k;
        unsigned lo = (sub < 4) ? (bits << (8 * sub)) : 0u, hi = (sub >= 4) ? (bits << (8 * (sub - 4))) : 0u;
        lo |= __shfl_xor(lo, 1); lo |= __shfl_xor(lo, 2); lo |= __shfl_xor(lo, 4);
        hi |= __shfl_xor(hi, 1); hi |= __shfl_xor(hi, 2); hi |= __shfl_xor(hi, 4);
        if (sub == 0) selm[q] = make_uint2(lo, hi);
    }
#endif
    __syncthreads();
    unsigned ulo = 0u, uhi = 0u;
    for (int q = 0; q < 32; ++q) { const uint2 s = selm[q]; ulo |= s.x; uhi |= s.y; }
    ulo = __builtin_amdgcn_readfirstlane(ulo); uhi = __builtin_amdgcn_readfirstlane(uhi);
    const unsigned long long U = ((unsigned long long)uhi << 32) | ulo;
    const uint2 ms = selm[r];
    const unsigned long long sel = ((unsigned long long)ms.y << 32) | ms.x;
    zero_o(o); m = NEGF; l = 0.f;
#ifndef X_NOSLC
    flash<K_SLC, M_SOFT>(smem, KS, 128, VST, SEQ, 0, __popcll(U), U, qf, o, m, l, t, cur, sel, 0.f, nullptr, tid);
#endif
    { const float g1 = sigmoidf_(__uint_as_float((unsigned)BG[tok * 128 + 16 + head] << 16)); acc_store(o, g1 / l, acc2, h); }
    zero_o(o); m = NEGF; l = 0.f;
    const int tlo = (q0 > 511 ? q0 - 511 : 0) >> 6;
#ifndef X_NOWIN
    flash<K_WIN, M_SOFT>(smem, KW, 128, VWT, SEQ, tlo, cur - tlo + 1, 0ull, qf, o, m, l, t, cur, 0ull, 0.f, nullptr, tid);
#endif
    { const float g2 = sigmoidf_(__uint_as_float((unsigned)BG[tok * 128 + 32 + head] << 16)); write_y(o, g2 / l, acc1, acc2, G + rowoff, Q + rowoff, h); }
}

#define XB_TMO      128
#define XB_XCNT(j)  (256  + 64 * (j))
#define XB_XSUB(j)  (1280 + 64 * (j))
#define XB_XGEN(j)  (2304 + 64 * (j))
#define XB_TOP      3328
#define XB_TOPGEN   3392
#define XCD_BAR_WORDS 3456
#define XB_SPIN_CAP (1u << 18)
#define LAS __attribute__((address_space(3)))
DI unsigned xb_ld(unsigned* p)              { return __hip_atomic_load(p, __ATOMIC_RELAXED, __HIP_MEMORY_SCOPE_AGENT); }
DI unsigned xb_add(unsigned* p, unsigned v) { return __hip_atomic_fetch_add(p, v, __ATOMIC_RELAXED, __HIP_MEMORY_SCOPE_AGENT); }
DI unsigned xb_xcc_id() { return (unsigned)__builtin_amdgcn_s_getreg((3 << 11) | 20) & 0xFu; }
#define XB_SPIN(cond, bar) do { unsigned _sp = 0; while (cond) { __builtin_amdgcn_s_sleep(1); \
    if ((++_sp & 255u) == 0u) { if (xb_ld(&(bar)[XB_TMO])) break; if (_sp > XB_SPIN_CAP) { atomicAdd(&(bar)[XB_TMO], 1u); break; } } } } while (0)
struct XcdBarrier { unsigned* bar; unsigned x; volatile LAS unsigned* st; };
DI XcdBarrier xcd_barrier_post(unsigned* bar, volatile LAS unsigned* st) {
    XcdBarrier b; b.bar = bar; b.x = xb_xcc_id(); b.st = st;
    if (threadIdx.x == 0) (void)xb_add(&bar[XB_XCNT(b.x)], 1u);
    return b;
}
DI void xcd_barrier_complete(unsigned* bar, unsigned x, unsigned& nloc, unsigned& nx) {
    const unsigned G = gridDim.x * gridDim.y * gridDim.z;
    unsigned sum, cnt, mine, sp = 0u;
    for (;;) {
        sum = 0u; cnt = 0u; mine = 0u;
#pragma unroll
        for (unsigned j = 0; j < 16; ++j) { const unsigned c = xb_ld(&bar[XB_XCNT(j)]); sum += c; cnt += (c > 0u) ? 1u : 0u; mine = (j == x) ? c : mine; }
        if (sum == G) break;
        __builtin_amdgcn_s_sleep(1);
        if ((++sp & 255u) == 0u) { if (xb_ld(&bar[XB_TMO])) break; if (sp > XB_SPIN_CAP) { atomicAdd(&bar[XB_TMO], 1u); break; } }
    }
    nloc = mine > 0u ? mine : 1u; nx = cnt > 0u ? cnt : 1u;
}
DI void xcd_barrier(const XcdBarrier& b) {
    asm volatile("s_waitcnt vmcnt(0)" ::: "memory");
    __syncthreads();
    if (threadIdx.x == 0) {
        unsigned* bar = b.bar;
        __builtin_amdgcn_s_waitcnt(0);
        unsigned nloc = b.st[0], nx = b.st[1];
        if (nloc == 0u) { xcd_barrier_complete(bar, b.x, nloc, nx); b.st[0] = nloc; b.st[1] = nx; }
        const unsigned old = xb_add(&bar[XB_XSUB(b.x)], 1u);
        const unsigned gen = old / nloc;
        if (old + 1u == (gen + 1u) * nloc) {
            __builtin_amdgcn_fence(__ATOMIC_RELEASE, "agent");
            asm volatile("s_waitcnt vmcnt(0)" ::: "memory");
            const unsigned og = xb_add(&bar[XB_TOP], 1u);
            const unsigned tg = og / nx;
            if (og + 1u == (tg + 1u) * nx) xb_add(&bar[XB_TOPGEN], 1u);
            else XB_SPIN(xb_ld(&bar[XB_TOPGEN]) == tg, bar);
            __builtin_amdgcn_fence(__ATOMIC_ACQUIRE, "agent");
            xb_add(&bar[XB_XGEN(b.x)], 1u);
            asm volatile("s_waitcnt vmcnt(0)" ::: "memory");
        } else {
            XB_SPIN(xb_ld(&bar[XB_XGEN(b.x)]) == gen, bar);
            __builtin_amdgcn_fence(__ATOMIC_ACQUIRE, "agent");
            asm volatile("s_waitcnt vmcnt(0)" ::: "memory");
        }
    }
    __syncthreads();
}

__global__ void __launch_bounds__(256, 2) mega(P p) {
    extern __shared__ __attribute__((aligned(16))) unsigned char smem[];
    cg::grid_group grid = cg::this_grid();
    const int tid = threadIdx.x, bid = blockIdx.x, nb = gridDim.x;
    const int lane = tid & 63, wave = tid >> 6;
    unsigned char* ws = p.ws;
    bf16_t* WIN = (bf16_t*)(ws + WS_WIN);
    bf16_t* WOUT = (bf16_t*)(ws + WS_WOUT);
    float* X = (float*)(ws + WS_X);
    bf16_t* A = (bf16_t*)(ws + WS_A);
    bf16_t* Q = (bf16_t*)(ws + WS_Q);
    bf16_t* Kb = (bf16_t*)(ws + WS_K);
    bf16_t* VT = (bf16_t*)(ws + WS_VT);
    bf16_t* G = (bf16_t*)(ws + WS_G);
    float* ROPE = (float*)(ws + WS_ROPE);
    float* SSQ = (float*)(ws + WS_SSQ);
    float* KMP = (float*)(ws + WS_KMP);
    bf16_t* CMPW = (bf16_t*)(ws + WS_CMPW);
    float* CBIAS = (float*)(ws + WS_CBIAS);
    float* ldsf = (float*)smem;
    volatile LAS unsigned* xbst = (volatile LAS unsigned*)(LAS unsigned char*)(smem) + LDS_XB / 4;
    if (tid < 4) xbst[tid] = 0u;
    __syncthreads();
    const XcdBarrier xbar = xcd_barrier_post((unsigned*)(ws + WS_BAR), xbst);
    grid.sync();

    phase_convert(p.w_in[0], DM, 8192, 8192, WIN, ldsf, tid, bid, nb);
    for (int L = 0; L < 4; ++L) phase_convert(sel4(L, p.w_out[0], p.w_out[1], p.w_out[2], p.w_out[3]), DM, DM, DM, WOUT + (size_t)L * DM * DM, ldsf, tid, bid, nb);
    phase_convert(p.cwk, 4096, 128, 128, CMPW, ldsf, tid, bid, nb);
    phase_convert(p.cwv, 4096, 128, 128, CMPW + 128 * 4096, ldsf, tid, bid, nb);
    for (int i = bid * 256 + tid; i < 4096 * 64; i += nb * 256) {
        const int pos = i >> 6, d = i & 63;
        const float inv_freq = expf(-9.210340371976184f * (float)d * (1.f / 64.f));
        const float ang = (float)pos * inv_freq;
        const double rev = (double)ang * 0.15915494309189535;
        const float fr = (float)(rev - rint(rev));
        ROPE[i] = __builtin_amdgcn_cosf(fr);
        ROPE[262144 + i] = __builtin_amdgcn_sinf(fr);
    }
    for (int cbk = bid; cbk < 64; cbk += nb) {
        const int which = tid >> 7, e = tid & 127;
        const float* W = which ? p.cwv : p.cwk;
        float s = 0.f;
#pragma unroll 8
        for (int k = cbk * 64; k < cbk * 64 + 64; ++k) s += p.cpos[k] * W[(size_t)k * 128 + e];
        CBIAS[cbk * 256 + tid] = s;
    }
    for (int row = bid * 4 + wave; row < NTOK; row += nb * 4) {
        const float4* xr = (const float4*)(p.x + (size_t)row * DM);
        const float4* gr = (const float4*)p.norm[0];
        float ss = 0.f;
#pragma unroll
        for (int i = 0; i < 8; ++i) {
            const float4 v = xr[lane + 64 * i], gg = gr[lane + 64 * i];
            ss += v.x * v.x + v.y * v.y + v.z * v.z + v.w * v.w;
            uint2 w; w.x = cvtpk(v.x * gg.x, v.y * gg.y); w.y = cvtpk(v.z * gg.z, v.w * gg.w);
            *(uint2*)(A + (size_t)row * DM + (lane + 64 * i) * 4) = w;
        }
#pragma unroll
        for (int sft = 32; sft >= 1; sft >>= 1) ss += __shfl_xor(ss, sft);
        if (lane < 16) SSQ[lane * NTOK + row] = (lane == 0) ? ss : 0.f;
    }
    xcd_barrier(xbar);

    for (int L = 0; L < 4; ++L) {
        const int kind = (L == 1) ? 1 : ((L == 2) ? 2 : 0);
        {
            const int NT = (kind == 2) ? 57 : 64;
            const float* qn = (L == 0) ? p.qn0 : ((L == 3) ? p.qn3 : p.qn2);
            const float* kn = (L == 0) ? p.kn0 : p.kn3;
            for (int it_ = 0; ; ++it_) {
                int mt, nt;
                if (!panel_tile(it_, bid, nb, NT, 8, mt, nt)) break;
                const int b = mt >> 4, s0 = (mt & 15) * 256;
                Epi e{};
                e.ssq = SSQ + mt * 256; e.s0 = s0; e.pos_mul = 1; e.pos_add = 0; e.rope = ROPE;
                if (kind != 2) {
                    const int sec = nt >> 4, hd = nt & 15;
                    if (sec == 0) { e.mode = (kind == 0) ? 1 : 0; e.dst = Q + (size_t)b * SEQ * DM + hd * 128; e.ld = DM; e.gain = qn; }
                    else if (sec == 1) { e.mode = (kind == 0) ? 1 : 0; e.dst = Kb + (size_t)(b * 16 + hd) * SEQ * 128; e.ld = 128; e.gain = kn;
                                         e.kmp = (kind == 0) ? KMP + ((size_t)(b * 16 + hd) * 32 + (mt & 15) * 2) * 128 : nullptr; }
                    else if (sec == 2) { e.mode = 2; e.dst = VT + (size_t)(b * 16 + hd) * 128 * SEQ; e.vtS = SEQ; }
                    else { e.mode = 0; e.dst = G + (size_t)b * SEQ * DM + hd * 128; e.ld = DM; }
                } else {
                    if (nt < 16) { e.mode = 1; e.dst = Q + (size_t)b * SEQ * DM + nt * 128; e.ld = DM; e.gain = qn; }
                    else if (nt < 40) {
                        const int which = (nt - 16) >> 2, gq = (nt - 16) & 3, bgi = b * 4 + gq;
                        const size_t hm = (size_t)bgi * SEQ * 128;
                        if (which == 0) { e.mode = 0; e.dst = (bf16_t*)(ws + WS_K) + hm; e.ld = 128; }
                        else if (which == 1) { e.mode = 0; e.dst = (bf16_t*)(ws + WS_K + 8 * MB) + hm; e.ld = 128; }
                        else if (which == 2) { e.mode = 1; e.dst = (bf16_t*)(ws + WS_K + 16 * MB) + hm; e.ld = 128; e.gain = p.ksn2; }
                        else if (which == 3) { e.mode = 2; e.dst = (bf16_t*)(ws + WS_VT) + hm; e.vtS = SEQ; }
                        else if (which == 4) { e.mode = 1; e.dst = (bf16_t*)(ws + WS_K + 24 * MB) + hm; e.ld = 128; e.gain = p.kwn2; }
                        else { e.mode = 2; e.dst = (bf16_t*)(ws + WS_VT + 8 * MB) + hm; e.vtS = SEQ; }
                    }
                    else if (nt < 56) { e.mode = 0; e.dst = G + (size_t)b * SEQ * DM + (nt - 40) * 128; e.ld = DM; }
                    else { e.mode = 0; e.dst = (bf16_t*)(ws + WS_VT + 18 * MB) + (size_t)b * SEQ * 128; e.ld = 128; }
                }
                gemm_tile(A + (size_t)mt * 256 * DM, DM, WIN + (size_t)nt * 128 * DM, DM, DM, smem, e, tid);
            }
        }
        xcd_barrier(xbar);
        if (kind == 2) {
            float* PART = (float*)(ws + WS_OACC);
            for (int tI = bid; tI < 128; tI += nb) {
                const int ksl = tI & 7, bgi = (tI >> 3) & 7, kv = tI >> 6;
                Epi e{};
                e.mode = 4; e.p32 = PART + (size_t)tI * 256 * 128;
                const bf16_t* Asrc = (const bf16_t*)(ws + WS_K + (size_t)kv * 8 * MB) + (size_t)bgi * SEQ * 128 + ksl * 512;
                gemm_tile(Asrc, 2048, CMPW + (size_t)kv * 128 * 4096 + ksl * 512, 4096, 512, smem, e, tid);
            }
            xcd_barrier(xbar);
            if (bid < 16) {
                float sb_ = 0.f;
                for (int i = 0; i < 64; ++i) sb_ += CBIAS[i * 256 + tid];
                ((float*)(smem + LDS_RED))[tid] = sb_;
                __syncthreads();
            }
            for (int tI = bid; tI < 16; tI += nb) {
                const int kv = tI >> 3, bgi = tI & 7;
                Epi e{};
                e.s0 = 0; e.rope = ROPE; e.cbias = (const float*)(smem + LDS_RED) + kv * 128;
                if (kv == 0) { e.mode = 1; e.gain = p.kcn2; e.dst = (bf16_t*)(ws + WS_VT + 16 * MB) + (size_t)bgi * 256 * 128; e.ld = 128; e.pos_mul = 16; e.pos_add = 31; }
                else { e.mode = 2; e.dst = (bf16_t*)(ws + WS_VT + 17 * MB) + (size_t)bgi * 128 * 256; e.vtS = 256; }
                reduce_tile(PART + (size_t)(kv * 64 + bgi * 8) * 256 * 128, 8, (size_t)256 * 128, smem, e, tid);
            }
            xcd_barrier(xbar);
        }
        for (int rd = 0; rd * nb < 1024; ++rd) {
            const int idx = snake(rd, bid, nb);
            if (idx >= 1024) continue;
#ifndef NO_MOBA
            if (kind == 0) moba_item(ws, smem, idx, tid);
#endif
#ifndef NO_SB
            if (kind == 1) sb_item(ws, smem, idx, tid);
#endif
#ifndef NO_NSA
            if (kind == 2) nsa_item(ws, smem, idx, tid);
#endif
        }
        xcd_barrier(xbar);
        for (int it_ = 0; ; ++it_) {
            int mt, nt;
            if (!panel_tile(it_, bid, nb, 16, 2, mt, nt)) break;
            Epi e{};
            e.mode = 3;
            const size_t off = (size_t)mt * 256 * DM + nt * 128;
            e.xold = ((L == 0) ? p.x : X) + off;
            e.xnew = ((L == 3) ? p.out : X) + off;
            if (L < 3) { e.anext = A + off; e.gnext = sel4(L, p.norm[1], p.norm[2], p.norm[3], p.norm[3]) + nt * 128; e.ssq_out = SSQ + (size_t)nt * NTOK + mt * 256; }
            gemm_tile(Q + (size_t)mt * 256 * DM, DM, WOUT + (size_t)L * DM * DM + (size_t)nt * 128 * DM, DM, DM, smem, e, tid);
        }
        if (L < 3) {
            const int Nn = (L + 1 == 2) ? 7216 : 8192, Np = (L + 1 == 2) ? 7296 : 8192;
            phase_convert(sel4(L, p.w_in[1], p.w_in[2], p.w_in[3], p.w_in[3]), DM, Nn, Np, WIN, ldsf, tid, bid, nb);
            xcd_barrier(xbar);
        }
    }
}

extern "C" void kernel_launch(void* const* d_in, const int* in_sizes, int n_in, void* d_out, int out_size, void* d_ws, size_t ws_size,
                              hipStream_t stream) {
    static int grid_blocks = 0;
    if (!grid_blocks) {
        if (n_in != 24 || ws_size < WS_END) { fprintf(stderr, "kernel_launch: unexpected inputs (%d) or workspace (%zu)\n", n_in, ws_size); grid_blocks = -1; return; }
        int dev = 0, cus = 0, per_cu = 0;
        (void)hipGetDevice(&dev);
        (void)hipDeviceGetAttribute(&cus, hipDeviceAttributeMultiprocessorCount, dev);
        (void)hipFuncSetAttribute((const void*)mega, hipFuncAttributeMaxDynamicSharedMemorySize, LDS_BYTES);
        (void)hipOccupancyMaxActiveBlocksPerMultiprocessor(&per_cu, (const void*)mega, 256, LDS_BYTES);
        if (per_cu < 1) per_cu = 1;
        if (per_cu > 2) per_cu = 2;
        grid_blocks = cus * per_cu;
    }
    if (grid_blocks < 0) return;
    P p{};
    p.x = (const float*)d_in[0];
    p.norm[0] = (const float*)d_in[1]; p.w_in[0] = (const float*)d_in[2]; p.qn0 = (const float*)d_in[3]; p.kn0 = (const float*)d_in[4]; p.w_out[0] = (const float*)d_in[5];
    p.norm[1] = (const float*)d_in[6]; p.w_in[1] = (const float*)d_in[7]; p.w_out[1] = (const float*)d_in[8];
    p.norm[2] = (const float*)d_in[9]; p.w_in[2] = (const float*)d_in[10]; p.qn2 = (const float*)d_in[11]; p.kcn2 = (const float*)d_in[12];
    p.ksn2 = (const float*)d_in[13]; p.kwn2 = (const float*)d_in[14]; p.cwk = (const float*)d_in[15]; p.cwv = (const float*)d_in[16];
    p.cpos = (const float*)d_in[17]; p.w_out[2] = (const float*)d_in[18];
    p.norm[3] = (const float*)d_in[19]; p.w_in[3] = (const float*)d_in[20]; p.qn3 = (const float*)d_in[21]; p.kn3 = (const float*)d_in[22]; p.w_out[3] = (const float*)d_in[23];
    p.out = (float*)d_out; p.ws = (unsigned char*)d_ws;
    if (hipMemsetAsync((unsigned char*)d_ws + WS_BAR, 0, XCD_BAR_WORDS * sizeof(unsigned), stream) != hipSuccess) { fprintf(stderr, "kernel_launch: barrier memset failed\n"); return; }
    void* args[] = {&p};
    hipError_t e = hipLaunchCooperativeKernel((const void*)mega, dim3(grid_blocks), dim3(256), args, LDS_BYTES, stream);
    if (e != hipSuccess) fprintf(stderr, "cooperative launch failed: %s (grid %d)\n", hipGetErrorString(e), grid_blocks);
}
#ifdef TEST_ATT
__global__ void __launch_bounds__(256, 2) test_att(unsigned char* ws) {
    extern __shared__ __attribute__((aligned(16))) unsigned char smem[];
    for (int idx = blockIdx.x; idx < 1024; idx += gridDim.x) {
#if TEST_ATT == 0
        moba_item(ws, smem, idx, threadIdx.x);
#elif TEST_ATT == 1
        sb_item(ws, smem, idx, threadIdx.x);
#else
        nsa_item(ws, smem, idx, threadIdx.x);
#endif
    }
}
#endif
```
